# Optimizing an MI355X kernel written in HIP

```python
import jax, jax.numpy as jnp
from jax import lax
import numpy as np

D_MODEL = 1024
BATCH = 8
SEQ = 2048
DEPTH = 1

CHUNK = 64
D_RNN = D_MODEL // 2
RNN_BLOCKS = 8
RNN_BLOCK_W = D_RNN // RNN_BLOCKS
RNN_CONV_W = 4
RG_C = 8.0
ATT_HEAD_DIM = 64
D_ATT = D_MODEL // 2
N_ATT_HEADS = D_ATT // ATT_HEAD_DIM
LOOKBACK = 8
BAND = (LOOKBACK + 1) * CHUNK
REL_CLIP = 128
D_MIX = D_RNN + D_ATT
D_IN = 2 * D_RNN + 3 * D_ATT
D_FF = 2816
FFN_CONV_W = 3
EPS = 1e-6
ADA_SCALE = 0.5
NEG_INF = -1e30

kernel_name = "hybrid_rglru_chunkattn_convffn_adaln"


def rmsnorm(x, g):
    xf = x.astype(jnp.float32)
    y = xf * lax.rsqrt(jnp.mean(xf * xf, axis=-1, keepdims=True) + EPS)
    return (y * g.astype(jnp.float32)).astype(x.dtype)


def modulate(h, shift, scale):
    return h * (1.0 + scale[:, None, :]) + shift[:, None, :]


def causal_dwconv(x, w, b):
    width = w.shape[0]
    seq = x.shape[1]
    xp = jnp.pad(x, ((0, 0), (width - 1, 0), (0, 0)))
    y = xp[:, 0:seq] * w[0]
    for k in range(1, width):
        y = y + xp[:, k:k + seq] * w[k]
    return y + b


def rg_lru_group(xr, gr, conv_w, conv_b, wa, ba, wx, bx, lam):
    bsz, seq, _ = xr.shape
    xc = causal_dwconv(xr, conv_w, conv_b)
    xb = xc.reshape(bsz, seq, RNN_BLOCKS, RNN_BLOCK_W)
    r = jax.nn.sigmoid(jnp.einsum('bsnc,ncd->bsnd', xb, wa).reshape(bsz, seq, D_RNN) + ba)
    i = jax.nn.sigmoid(jnp.einsum('bsnc,ncd->bsnd', xb, wx).reshape(bsz, seq, D_RNN) + bx)
    log_a = RG_C * r.astype(jnp.float32) * jax.nn.log_sigmoid(lam.astype(jnp.float32))
    a = jnp.exp(log_a)
    mult = jnp.sqrt(-jnp.expm1(2.0 * log_a))
    bterm = mult * (i * xc).astype(jnp.float32)

    def combine(left, right):
        a1, b1 = left
        a2, b2 = right
        return a1 * a2, a2 * b1 + b2

    _, h = lax.associative_scan(combine, (a, bterm), axis=1)
    return h.astype(xr.dtype) * jax.nn.gelu(gr)


def chunk_attention_group(q, k, v, rel_bias):
    bsz, seq, _ = q.shape
    nc = seq // CHUNK
    shp = (bsz, nc, CHUNK, N_ATT_HEADS, ATT_HEAD_DIM)
    q = q.reshape(shp)
    k = k.reshape(shp)
    v = v.reshape(shp)
    pad = ((0, 0), (LOOKBACK, 0), (0, 0), (0, 0), (0, 0))
    kp = jnp.pad(k, pad)
    vp = jnp.pad(v, pad)
    band_idx = jnp.arange(nc)[:, None] + jnp.arange(LOOKBACK + 1)[None, :]
    kb = kp[:, band_idx].reshape(bsz, nc, BAND, N_ATT_HEADS, ATT_HEAD_DIM)
    vb = vp[:, band_idx].reshape(bsz, nc, BAND, N_ATT_HEADS, ATT_HEAD_DIM)
    qi = jnp.arange(CHUNK)
    kj = jnp.arange(BAND)
    rel = LOOKBACK * CHUNK + qi[:, None] - kj[None, :]
    bias = rel_bias[:, jnp.clip(rel, -REL_CLIP, REL_CLIP) + REL_CLIP]
    valid = (jnp.arange(nc)[:, None] - LOOKBACK + kj[None, :] // CHUNK) >= 0
    scale = ATT_HEAD_DIM ** -0.5
    s = jnp.einsum('bnqhd,bnkhd->bnhqk', q, kb).astype(jnp.float32) * scale
    s = s + bias.astype(jnp.float32)[None, None]
    s = jnp.where(valid[None, :, None, None, :], s, NEG_INF)
    p = jax.nn.softmax(s, axis=-1).astype(v.dtype)
    o = jnp.einsum('bnhqk,bnkhd->bnqhd', p, vb)
    return o.reshape(bsz, seq, D_ATT)


def setup_inputs(seed: int = 0) -> dict:
    key = jax.random.key(seed)
    ks = jax.random.split(key, 24)
    f32 = jnp.float32
    nrm = lambda k, shape, s: jax.random.normal(k, shape, f32) * s
    u = jax.random.uniform(ks[12], (DEPTH, D_RNN), f32, 0.9, 0.999)
    return {
        "x": nrm(ks[0], (BATCH, SEQ, D_MODEL), 1.0),
        "c": nrm(ks[1], (BATCH, D_MODEL), 1.0),
        "ada_w": nrm(ks[2], (DEPTH, D_MODEL, 6 * D_MODEL), ADA_SCALE * D_MODEL ** -0.5),
        "ada_b": nrm(ks[3], (DEPTH, 6 * D_MODEL), 0.02),
        "norm1_g": 1.0 + nrm(ks[4], (DEPTH, D_MODEL), 0.02),
        "w_in": nrm(ks[5], (DEPTH, D_MODEL, D_IN), D_MODEL ** -0.5),
        "rnn_conv_w": nrm(ks[6], (DEPTH, RNN_CONV_W, D_RNN), RNN_CONV_W ** -0.5),
        "rnn_conv_b": nrm(ks[7], (DEPTH, D_RNN), 0.02),
        "rg_wa": nrm(ks[8], (DEPTH, RNN_BLOCKS, RNN_BLOCK_W, RNN_BLOCK_W), RNN_BLOCK_W ** -0.5),
        "rg_ba": nrm(ks[9], (DEPTH, D_RNN), 0.02),
        "rg_wx": nrm(ks[10], (DEPTH, RNN_BLOCKS, RNN_BLOCK_W, RNN_BLOCK_W), RNN_BLOCK_W ** -0.5),
        "rg_bx": nrm(ks[11], (DEPTH, D_RNN), 0.02),
        "rg_lambda": jnp.log(u) - jnp.log1p(-u),
        "rel_bias": nrm(ks[13], (DEPTH, N_ATT_HEADS, 2 * REL_CLIP + 1), 0.5),
        "w_out": nrm(ks[14], (DEPTH, D_MIX, D_MODEL), D_MIX ** -0.5),
        "norm2_g": 1.0 + nrm(ks[15], (DEPTH, D_MODEL), 0.02),
        "w_up": nrm(ks[16], (DEPTH, D_MODEL, 2 * D_FF), D_MODEL ** -0.5),
        "ffn_conv_w": nrm(ks[17], (DEPTH, FFN_CONV_W, 2 * D_FF), FFN_CONV_W ** -0.5),
        "ffn_conv_b": nrm(ks[18], (DEPTH, 2 * D_FF), 0.02),
        "w_down": nrm(ks[19], (DEPTH, D_FF, D_MODEL), D_FF ** -0.5),
        "final_g": 1.0 + nrm(ks[20], (D_MODEL,), 0.02),
    }


def reference(x, c, ada_w, ada_b, norm1_g, w_in, rnn_conv_w, rnn_conv_b, rg_wa, rg_ba, rg_wx, rg_bx,
              rg_lambda, rel_bias, w_out, norm2_g, w_up, ffn_conv_w, ffn_conv_b, w_down, final_g):
    splits = [D_RNN, 2 * D_RNN, 2 * D_RNN + D_ATT, 2 * D_RNN + 2 * D_ATT]
    for l in range(DEPTH):
        mod = jax.nn.silu(c) @ ada_w[l] + ada_b[l]
        sh1, sc1, g1, sh2, sc2, g2 = jnp.split(mod, 6, axis=-1)
        h = modulate(rmsnorm(x, norm1_g[l]), sh1, sc1)
        proj = h @ w_in[l]
        xr, gr, q, k, v = jnp.split(proj, splits, axis=-1)
        y_rnn = rg_lru_group(xr, gr, rnn_conv_w[l], rnn_conv_b[l], rg_wa[l], rg_ba[l],
                             rg_wx[l], rg_bx[l], rg_lambda[l])
        y_att = chunk_attention_group(q, k, v, rel_bias[l])
        y = jnp.concatenate([y_rnn, y_att], axis=-1) @ w_out[l]
        x = x + g1[:, None, :] * y
        h = modulate(rmsnorm(x, norm2_g[l]), sh2, sc2)
        up = causal_dwconv(h @ w_up[l], ffn_conv_w[l], ffn_conv_b[l])
        ug, uv = jnp.split(up, 2, axis=-1)
        x = x + g2[:, None, :] * ((jax.nn.silu(ug) * uv) @ w_down[l])
    return rmsnorm(x, final_g)
```

```cpp
#include <hip/hip_runtime.h>
#include <hip/hip_bf16.h>
#include <hip/hip_cooperative_groups.h>
#include <cstdio>
namespace cg = cooperative_groups;

#define LAS __attribute__((address_space(3)))
typedef short bf16x8 __attribute__((ext_vector_type(8)));
typedef float f32x4 __attribute__((ext_vector_type(4)));
typedef unsigned short u16;
typedef unsigned u32x4 __attribute__((ext_vector_type(4)));
typedef unsigned u32x2 __attribute__((ext_vector_type(2)));

constexpr int D = 1024, BATCH = 8, SEQ = 2048, MTOK = BATCH * SEQ;
constexpr int DRNN = 512, DATT = 512, DIN = 2560, DFF = 2816, NUP = 5632;
constexpr int NTHREADS = 512;
constexpr int PST = 1536;
constexpr float EPS = 1e-6f;
constexpr int C_XR = 0, C_GR = 512, C_Q = 1024, C_K = 1536, C_V = 2048;
constexpr int MO_SH1 = 0, MO_SC1 = 1024, MO_G1 = 2048, MO_SH2 = 3072, MO_SC2 = 4096, MO_G2 = 5120;

constexpr size_t OFF_BAR = 5u << 20;
constexpr size_t OFF_XCH = OFF_BAR + 16384;
constexpr size_t OFF_MOD = OFF_XCH + (1u << 20);
constexpr size_t OFF_RTOT = OFF_MOD + 196608;
constexpr size_t ZERO_BYTES = 16384 + (1u << 20) + 196608 + (1u << 20);
static_assert(OFF_BAR + ZERO_BYTES <= (8u << 20), "zero region");
constexpr size_t OFF_LSL = 196608;
constexpr size_t OFF_WAT = 200704;
constexpr size_t OFF_WXT = OFF_WAT + 65536;
constexpr size_t OFF_SIDE = 2u << 20;
constexpr size_t OFF_WIN = 8u << 20;
constexpr size_t OFF_WOUT = OFF_WIN + (size_t)DIN * D * 2;
constexpr size_t OFF_WUP = OFF_WOUT + (size_t)D * D * 2;
constexpr size_t OFF_WDN = OFF_WUP + (size_t)NUP * D * 2;
constexpr size_t OFF_H = OFF_WDN + (size_t)D * DFF * 2;
constexpr size_t OFF_PROJ = OFF_H + (size_t)MTOK * D * 2;
constexpr size_t OFF_YMIX = OFF_PROJ + (size_t)MTOK * PST * 2;
constexpr size_t OFF_HL = OFF_YMIX + (size_t)MTOK * D * 2;
constexpr size_t OFF_AC = OFF_HL + (size_t)MTOK * DRNN * 4;
constexpr size_t OFF_X1B = OFF_AC;
constexpr size_t OFF_KF = OFF_AC + (size_t)MTOK * DRNN * 4;
constexpr size_t OFF_VT = OFF_KF + (size_t)MTOK * DATT * 2;
constexpr size_t WS_END = OFF_VT + (size_t)MTOK * DATT * 2;
static_assert(WS_END <= (256u << 20), "workspace");
static_assert((size_t)MTOK * DFF * 2 <= (size_t)MTOK * PST * 2 + (size_t)MTOK * D * 2 + (size_t)MTOK * DRNN * 4, "act fits over proj+ymix+hl");

constexpr int LDS_MAIN = 256 * 528;
constexpr int LDS_BYTES = LDS_MAIN + 16;

struct Params {
    const float *x, *c, *ada_w, *ada_b, *norm1_g, *w_in, *rnn_conv_w, *rnn_conv_b, *rg_wa, *rg_ba, *rg_wx, *rg_bx, *rg_lambda,
        *rel_bias, *w_out, *norm2_g, *w_up, *ffn_conv_w, *ffn_conv_b, *w_down, *final_g;
    float* out;
    unsigned char* ws;
    int ph_lo, ph_hi;
};

__device__ __forceinline__ unsigned opaque_zero() { unsigned z; asm volatile("s_mov_b32 %0, 0" : "=s"(z)); return z; }
__device__ __forceinline__ int opaque_bid() { int t; asm volatile("s_mov_b32 %0, %1" : "=s"(t) : "s"(blockIdx.x)); return t; }
__device__ __forceinline__ int opaque_tid() { int t; asm volatile("v_mov_b32 %0, %1" : "=v"(t) : "v"(threadIdx.x)); return t; }
__device__ __forceinline__ unsigned pk2(float lo, float hi) { unsigned r; asm("v_cvt_pk_bf16_f32 %0, %1, %2" : "=v"(r) : "v"(lo), "v"(hi)); return r; }
__device__ __forceinline__ float bflo(unsigned u) { return __uint_as_float(u << 16); }
__device__ __forceinline__ float bfhi(unsigned u) { return __uint_as_float(u & 0xffff0000u); }
__device__ __forceinline__ float wave_sum(float v) {
#pragma unroll
    for (int o = 1; o < 64; o <<= 1) v += __shfl_xor(v, o);
    return v;
}
__device__ __forceinline__ float sigmoidf_(float v) { return __builtin_amdgcn_rcpf(1.f + __expf(-v)); }
__device__ __forceinline__ float siluf_(float v) { return v * __builtin_amdgcn_rcpf(1.f + __expf(-v)); }
__device__ __forceinline__ float gelu_tanh(float v) {
    const float u = 0.7978845608028654f * (v + 0.044715f * v * v * v);
    const float t = 1.f - 2.f * __builtin_amdgcn_rcpf(__expf(2.f * u) + 1.f);
    return 0.5f * v * (1.f + t);
}


#define XB_TMO      128
#define XB_XCNT(j)  (256  + 64 * (j))
#define XB_XSUB(j)  (1280 + 64 * (j))
#define XB_XGEN(j)  (2304 + 64 * (j))
#define XB_TOP      3328
#define XB_TOPGEN   3392
#define XCD_BAR_WORDS 3456
#define XB_SPIN_CAP (1u << 20)
__device__ __forceinline__ unsigned xb_ld(unsigned* p)              { return __hip_atomic_load(p, __ATOMIC_RELAXED, __HIP_MEMORY_SCOPE_AGENT); }
__device__ __forceinline__ unsigned xb_add(unsigned* p, unsigned v) { return __hip_atomic_fetch_add(p, v, __ATOMIC_RELAXED, __HIP_MEMORY_SCOPE_AGENT); }
__device__ __forceinline__ unsigned xb_xcc_id() { return (unsigned)__builtin_amdgcn_s_getreg((3 << 11) | 20) & 0xFu; }
#define XB_SPIN(cond, bar) do { unsigned _sp = 0; while (cond) { __builtin_amdgcn_s_sleep(1); \
    if ((++_sp & 255u) == 0u) { if (xb_ld(&(bar)[XB_TMO])) break; if (_sp > XB_SPIN_CAP) { atomicAdd(&(bar)[XB_TMO], 1u); break; } } } } while (0)
struct XcdBarrier { unsigned* bar; unsigned x; volatile LAS unsigned* st; };
__device__ __forceinline__ XcdBarrier xcd_barrier_post(unsigned* bar, volatile LAS unsigned* st) {
    XcdBarrier b; b.bar = bar; b.x = xb_xcc_id(); b.st = st;
    if (threadIdx.x == 0) (void)xb_add(&bar[XB_XCNT(b.x)], 1u);
    return b;
}
__device__ __forceinline__ void xcd_barrier_complete(unsigned* bar, unsigned x, unsigned& nloc, unsigned& nx) {
    const unsigned G = gridDim.x * gridDim.y * gridDim.z;
    unsigned sum, cnt, mine, sp = 0u;
    for (;;) {
        sum = 0u; cnt = 0u; mine = 0u;
#pragma unroll
        for (unsigned j = 0; j < 16; ++j) { const unsigned c = xb_ld(&bar[XB_XCNT(j)]); sum += c; cnt += (c > 0u) ? 1u : 0u; mine = (j == x) ? c : mine; }
        if (sum == G) break;
        __builtin_amdgcn_s_sleep(1);
        if ((++sp & 255u) == 0u) { if (xb_ld(&bar[XB_TMO])) break; if (sp > XB_SPIN_CAP) { atomicAdd(&bar[XB_TMO], 1u); break; } }
    }
    nloc = mine > 0u ? mine : 1u; nx = cnt > 0u ? cnt : 1u;
}
__device__ __forceinline__ void xcd_barrier(const XcdBarrier& b) {
    asm volatile("s_waitcnt vmcnt(0)" ::: "memory");
    __syncthreads();
    if (threadIdx.x == 0) {
        unsigned* bar = b.bar;
        __builtin_amdgcn_s_waitcnt(0);
        unsigned nloc = b.st[0], nx = b.st[1];
        if (nloc == 0u) { xcd_barrier_complete(bar, b.x, nloc, nx); b.st[0] = nloc; b.st[1] = nx; }
        const unsigned old = xb_add(&bar[XB_XSUB(b.x)], 1u);
        const unsigned gen = old / nloc;
        if (old + 1u == (gen + 1u) * nloc) {
            __builtin_amdgcn_fence(__ATOMIC_RELEASE, "agent");
            asm volatile("s_waitcnt vmcnt(0)" ::: "memory");
            const unsigned og = xb_add(&bar[XB_TOP], 1u);
            const unsigned tg = og / nx;
            if (og + 1u == (tg + 1u) * nx) xb_add(&bar[XB_TOPGEN], 1u);
            else XB_SPIN(xb_ld(&bar[XB_TOPGEN]) == tg, bar);
            __builtin_amdgcn_fence(__ATOMIC_ACQUIRE, "agent");
            xb_add(&bar[XB_XGEN(b.x)], 1u);
            asm volatile("s_waitcnt vmcnt(0)" ::: "memory");
        } else {
            XB_SPIN(xb_ld(&bar[XB_XGEN(b.x)]) == gen, bar);
            __builtin_amdgcn_fence(__ATOMIC_ACQUIRE, "agent");
            asm volatile("s_waitcnt vmcnt(0)" ::: "memory");
        }
    }
    __syncthreads();
}

constexpr int BM = 256, BK = 64, HALF = 128, HTB = HALF * BK * 2;
__device__ __forceinline__ int lds_byte(int r, int c) {
    int st = (r >> 4) * 2 + (c >> 5), rr = r & 15, cc = c & 31, ob = rr * 64 + cc * 2;
    return st * 1024 + (ob ^ (((ob >> 9) & 1) << 5));
}
__device__ __forceinline__ void stage_rc(int b, int& R, int& C) {
    int st = b / 1024, sb = b % 1024, swz = sb ^ (((sb >> 9) & 1) << 5);
    R = (st >> 1) * 16 + swz / 64; C = (st & 1) * 32 + (swz % 64) / 2;
}
#define G_SA(b, h) (((b) * 2 + (h)) * HTB)
#define G_SB(b, h) ((4 + (b) * 2 + (h)) * HTB)
#define G_STAGE(bufoff, gbase, voff) do { _Pragma("unroll") for (int _i = 0; _i < 2; ++_i) \
        __builtin_amdgcn_global_load_lds((const unsigned*)((const char*)(gbase) + (voff)[_i]), (LAS unsigned*)(lds + (bufoff) + ldsw + _i * 8192), 16, 0, 0); } while (0)
#define G_LDA(dst, b, h) do { _Pragma("unroll") for (int m = 0; m < 4; ++m) _Pragma("unroll") for (int k = 0; k < 2; ++k) dst[m][k] = *(const LAS bf16x8*)(lds + G_SA(b, h) + aoff + m * 2048 + k * 1024); } while (0)
#define G_LDB(dst, b, h) do { _Pragma("unroll") for (int n = 0; n < 2; ++n) _Pragma("unroll") for (int k = 0; k < 2; ++k) dst[n][k] = *(const LAS bf16x8*)(lds + G_SB(b, h) + boff + n * 2048 + k * 1024); } while (0)
#define G_MMA(ai, bj, At, Bt) do { __builtin_amdgcn_s_setprio(1); _Pragma("unroll") for (int m = 0; m < 4; ++m) _Pragma("unroll") for (int n = 0; n < 2; ++n) _Pragma("unroll") for (int k = 0; k < 2; ++k) \
        acc[ai][bj][m][n] = __builtin_amdgcn_mfma_f32_16x16x32_bf16(Bt[n][k], At[m][k], acc[ai][bj][m][n], 0, 0, 0); __builtin_amdgcn_s_setprio(0); } while (0)
#define G_WAIT_V(n) asm volatile("s_waitcnt vmcnt(" #n ")" ::: "memory")
#define G_WAIT_L(n) asm volatile("s_waitcnt lgkmcnt(" #n ")" ::: "memory")
#define G_BAR __builtin_amdgcn_s_barrier()
#define G_SCHED __builtin_amdgcn_sched_barrier(0)

template <class Hook>
__device__ __forceinline__ void gemm_tile(LAS unsigned char* lds, const char* cA, const char* cB, int K, f32x4 (&acc)[2][2][4][2], bool has_hook, const Hook& hook) {
    const int tid = opaque_tid(), wid = __builtin_amdgcn_readfirstlane(tid >> 6), lane = tid & 63, wr = wid >> 2, wc = wid & 3, fr = lane & 15, fq = lane >> 4;
    const int nt = K / BK;
    unsigned voff[2];
#pragma unroll
    for (int i = 0; i < 2; ++i) { int R, C; stage_rc(tid * 16 + i * 8192, R, C); voff[i] = (unsigned)(R * K + C) * 2u; }
    const size_t kstep = (size_t)(BK * 2);
    const size_t hstep = (size_t)HALF * K * 2;
    const unsigned ldsw = (unsigned)wid * 1024u;
    const int aoff = lds_byte(wr * 64 + fr, fq * 8), boff = lds_byte(wc * 32 + fr, fq * 8);
    bf16x8 At[4][2], B0[2][2], B1[2][2];
    G_WAIT_V(0);
    __syncthreads();
    G_STAGE(G_SB(0, 0), cB, voff); G_STAGE(G_SA(0, 0), cA, voff); G_STAGE(G_SB(0, 1), cB + hstep, voff); G_STAGE(G_SA(0, 1), cA + hstep, voff);
    if (has_hook) {
        hook();
        if (wr == 1) G_BAR;
        G_WAIT_V(8); G_BAR;
    } else {
        if (wr == 1) G_BAR;
        G_WAIT_V(4); G_BAR;
    }
#pragma unroll
    for (int a = 0; a < 2; ++a)
#pragma unroll
        for (int b = 0; b < 2; ++b)
#pragma unroll
            for (int m = 0; m < 4; ++m)
#pragma unroll
                for (int n = 0; n < 2; ++n) acc[a][b][m][n] = (f32x4){0.f, 0.f, 0.f, 0.f};
    G_STAGE(G_SB(1, 0), cB + kstep, voff); G_STAGE(G_SA(1, 0), cA + kstep, voff); G_STAGE(G_SB(1, 1), cB + hstep + kstep, voff);
    G_WAIT_V(6); G_BAR;
    for (int t = 0; t < nt - 2; t += 2) {
        const char* a1 = cA + (size_t)(t + 1) * kstep; const char* a2 = cA + (size_t)(t + 2) * kstep; const char* a3 = cA + (size_t)(t + 3) * kstep;
        const char* b2 = cB + (size_t)(t + 2) * kstep; const char* b3 = cB + (size_t)(t + 3) * kstep;
        G_LDB(B0, 0, 0); G_SCHED; G_LDA(At, 0, 0); G_STAGE(G_SA(1, 1), a1 + hstep, voff);
        G_WAIT_L(8); G_BAR; G_WAIT_L(0); G_MMA(0, 0, At, B0); G_BAR; G_SCHED;
        G_LDB(B1, 0, 1); G_STAGE(G_SB(0, 0), b2, voff);
        G_BAR; G_WAIT_L(0); G_MMA(0, 1, At, B1); G_BAR;
        G_LDA(At, 0, 1); G_STAGE(G_SA(0, 0), a2, voff);
        G_BAR; G_WAIT_L(0); G_MMA(1, 0, At, B0); G_BAR; G_SCHED;
        G_STAGE(G_SB(0, 1), b2 + hstep, voff);
        G_WAIT_V(6); G_BAR; G_MMA(1, 1, At, B1); G_BAR;
        G_LDB(B0, 1, 0); G_SCHED; G_LDA(At, 1, 0); G_STAGE(G_SA(0, 1), a2 + hstep, voff);
        G_WAIT_L(8); G_BAR; G_WAIT_L(0); G_MMA(0, 0, At, B0); G_BAR; G_SCHED;
        G_LDB(B1, 1, 1); G_STAGE(G_SB(1, 0), b3, voff);
        G_BAR; G_WAIT_L(0); G_MMA(0, 1, At, B1); G_BAR;
        G_LDA(At, 1, 1); G_STAGE(G_SA(1, 0), a3, voff);
        G_BAR; G_WAIT_L(0); G_MMA(1, 0, At, B0); G_BAR; G_SCHED;
        G_STAGE(G_SB(1, 1), b3 + hstep, voff);
        G_WAIT_V(6); G_BAR; G_MMA(1, 1, At, B1); G_BAR;
    }
    {   const char* aL = cA + (size_t)(nt - 1) * kstep;
        G_LDB(B0, 0, 0); G_LDA(At, 0, 0); G_STAGE(G_SA(1, 1), aL + hstep, voff);
        G_BAR; G_WAIT_L(0); G_MMA(0, 0, At, B0); G_BAR;
        G_LDB(B1, 0, 1); G_BAR; G_WAIT_L(0); G_MMA(0, 1, At, B1); G_BAR;
        G_LDA(At, 0, 1); G_WAIT_V(4); G_BAR; G_WAIT_L(0); G_MMA(1, 0, At, B0); G_MMA(1, 1, At, B1); G_BAR; }
    {   G_LDB(B0, 1, 0); G_LDA(At, 1, 0); G_WAIT_V(2); G_BAR; G_WAIT_L(0); G_MMA(0, 0, At, B0); G_BAR;
        G_LDB(B1, 1, 1); G_WAIT_V(0); G_BAR; G_WAIT_L(0); G_MMA(0, 1, At, B1); G_BAR;
        G_LDA(At, 1, 1); G_BAR; G_WAIT_L(0); G_MMA(1, 0, At, B0); G_MMA(1, 1, At, B1); G_BAR; }
    if (wr == 0) G_BAR;
}

__device__ __forceinline__ void st16_pair(u16* p32  , unsigned p0x, unsigned p0y, unsigned p1x, unsigned p1y, int fq) {
    const auto r0 = __builtin_amdgcn_permlane16_swap(p0x, p1x, false, false);
    const auto r1 = __builtin_amdgcn_permlane16_swap(p0y, p1y, false, false);
    *(u32x4*)(p32 + (fq & 1) * 16 + (fq >> 1) * 8) = (u32x4){(unsigned)r0[0], (unsigned)r1[0], (unsigned)r0[1], (unsigned)r1[1]};
}
__device__ __forceinline__ void st16_wt(void* base  , unsigned byte_off, u32x4 v) {
    const auto rs = __builtin_amdgcn_make_buffer_rsrc(base, 0, 0x7ffffffc, 0x00020000);
    __builtin_amdgcn_raw_buffer_store_b128(v, rs, (int)byte_off, 0, 16);
}
struct EpiProj {
    u16* O; u16* Kf; u16* Vf;
    __device__ __forceinline__ void operator()(LAS unsigned char* lds, const f32x4 (&acc)[2][2][4][2], int pm, int pn) const {
        const int tid = opaque_tid(), wid = tid >> 6, lane = tid & 63, wr = wid >> 2, wc = wid & 3, fr = lane & 15, fq = lane >> 4;
        if (pn < 6) {
#pragma unroll
            for (int ai = 0; ai < 2; ++ai)
#pragma unroll
                for (int m = 0; m < 4; ++m) {
                    const int row = pm * 256 + ai * 128 + wr * 64 + m * 16 + fr;
#pragma unroll
                    for (int bj = 0; bj < 2; ++bj) {
                        const f32x4 a0 = acc[ai][bj][m][0], a1 = acc[ai][bj][m][1];
                        st16_pair(O + (size_t)row * PST + pn * 256 + bj * 128 + wc * 32, pk2(a0.x, a0.y), pk2(a0.z, a0.w), pk2(a1.x, a1.y), pk2(a1.z, a1.w), fq);
                    }
                }
        } else if (pn < 8) {
            const int b = (pm * 256) / SEQ, s0 = (pm * 256) & (SEQ - 1);
#pragma unroll
            for (int bj = 0; bj < 2; ++bj)
#pragma unroll
                for (int n = 0; n < 2; ++n) {
                    const int colk = (pn - 6) * 256 + bj * 128 + wc * 32 + n * 16 + fq * 4;
                    const int hh = colk >> 6, d = colk & 63;
                    u16* kb_ = Kf + ((size_t)(b * 8 + hh) * 64 * 4 + (d >> 4)) * 512 + ((d >> 3) & 1) * 256 + (d & 7);
#pragma unroll
                    for (int ai = 0; ai < 2; ++ai)
#pragma unroll
                        for (int m = 0; m < 4; ++m) {
                            const int sk = s0 + ai * 128 + wr * 64 + m * 16 + fr;
                            const f32x4 a = acc[ai][bj][m][n];
                            u32x2 o; o.x = pk2(a.x, a.y); o.y = pk2(a.z, a.w);
                            *(u32x2*)(kb_ + (size_t)(sk >> 5) * 2048 + (sk & 31) * 8) = o;
                        }
                }
        } else {
            const int b = (pm * 256) / SEQ, s0 = (pm * 256) & (SEQ - 1);
            const int gk = (fr >> 2) & 1, jj = (fr >> 3) * 4 + (fr & 3);
#pragma unroll
            for (int bj = 0; bj < 2; ++bj)
#pragma unroll
                for (int n = 0; n < 2; ++n) {
                    const int colv = (pn - 8) * 256 + bj * 128 + wc * 32 + n * 16 + fq * 4;
                    const int hh = colv >> 6, d = colv & 63;
                    u16* vb_ = Vf + (((size_t)(b * 8 + hh) * 128 * 2 + (d >> 5)) * 64 + gk * 32 + (d & 31)) * 8 + jj;
#pragma unroll
                    for (int ai = 0; ai < 2; ++ai)
#pragma unroll
                        for (int m = 0; m < 4; ++m) {
                            const int kg = (s0 + ai * 128 + wr * 64 + m * 16) >> 4;
                            const f32x4 a = acc[ai][bj][m][n];
                            const unsigned lo = pk2(a.x, a.y), hi = pk2(a.z, a.w);
                            u16* v = vb_ + (size_t)kg * 1024;
                            v[0] = (u16)(lo & 0xffff); v[8] = (u16)(lo >> 16); v[16] = (u16)(hi & 0xffff); v[24] = (u16)(hi >> 16);
                        }
                }
        }
    }
};
struct EpiResid {
    const float* src; float* out; const float* gate;
    __device__ __forceinline__ void operator()(LAS unsigned char* lds, const f32x4 (&acc)[2][2][4][2], int pm, int pn) const {
        const int tid = opaque_tid(), wid = tid >> 6, lane = tid & 63, wr = wid >> 2, wc = wid & 3, fr = lane & 15, fq = lane >> 4;
        const int b = (pm * 256) / SEQ;
#pragma unroll
        for (int bj = 0; bj < 2; ++bj)
#pragma unroll
            for (int n = 0; n < 2; ++n) {
                const int col = pn * 256 + bj * 128 + wc * 32 + n * 16 + fq * 4;
                const float4 g = *(const float4*)(gate + b * 6144 + col);
#pragma unroll
                for (int ai = 0; ai < 2; ++ai)
#pragma unroll
                    for (int m = 0; m < 4; ++m) {
                        const int row = pm * 256 + ai * 128 + wr * 64 + m * 16 + fr;
                        const f32x4 a = acc[ai][bj][m][n];
                        const float4 s = *(const float4*)(src + (size_t)row * D + col);
                        float4 o; o.x = s.x + g.x * a.x; o.y = s.y + g.y * a.y; o.z = s.z + g.z * a.z; o.w = s.w + g.w * a.w;
                        *(float4*)(out + (size_t)row * D + col) = o;
                    }
            }
    }
};

typedef __attribute__((address_space(1))) unsigned long long gu64;
#define RLX_AGENT __ATOMIC_RELAXED, __HIP_MEMORY_SCOPE_AGENT
template <int MODE>
struct EpiResidNorm {
    const float* src; const float* gate; u16* x1b; const float* gain; const float* mod; int mo_sh, mo_sc; u16* hout; float* fout; unsigned long long* xch; unsigned tag;
    __device__ __forceinline__ void operator()(LAS unsigned char* lds, f32x4 (&acc)[2][2][4][2], int pm, int pn) const {
        const int tid = opaque_tid(), wid = tid >> 6, lane = tid & 63, wr = wid >> 2, wc = wid & 3, fr = lane & 15, fq = lane >> 4;
        const int b = (pm * 256) / SEQ;
        float ss[2][4];
#pragma unroll
        for (int ai = 0; ai < 2; ++ai)
#pragma unroll
            for (int m = 0; m < 4; ++m) ss[ai][m] = 0.f;
        if (MODE == 0) {
        float4 sv4[4]; float4 g = *(const float4*)(gate + b * 6144 + pn * 256 + wc * 32 + fq * 4), gn = g;
#define ERN_LOAD4(u) do { _Pragma("unroll") for (int m = 0; m < 4; ++m) { \
            const int col_ = pn * 256 + ((u) >> 2) * 128 + wc * 32 + (((u) >> 1) & 1) * 16 + fq * 4, row_ = pm * 256 + ((u) & 1) * 128 + wr * 64 + m * 16 + fr; \
            sv4[m] = *(const float4*)(src + (size_t)row_ * D + col_); } } while (0)
        ERN_LOAD4(0);
#pragma unroll
        for (int u = 0; u < 8; ++u) {
            const int bj = u >> 2, n = (u >> 1) & 1, ai = u & 1;
            const int col = pn * 256 + bj * 128 + wc * 32 + n * 16 + fq * 4;
            g = gn;
#pragma unroll
            for (int m = 0; m < 4; ++m) {
                f32x4 a = acc[ai][bj][m][n];
                const float4 sx = sv4[m];
                a.x = sx.x + g.x * a.x; a.y = sx.y + g.y * a.y; a.z = sx.z + g.z * a.z; a.w = sx.w + g.w * a.w;
                acc[ai][bj][m][n] = a;
                ss[ai][m] += (a.x * a.x + a.y * a.y) + (a.z * a.z + a.w * a.w);
            }
            __builtin_amdgcn_sched_barrier(0);
            if (u < 7) { ERN_LOAD4(u + 1); if (((u + 1) & 1) == 0) gn = *(const float4*)(gate + b * 6144 + pn * 256 + ((u + 1) >> 2) * 128 + wc * 32 + (((u + 1) >> 1) & 1) * 16 + fq * 4); }
            __builtin_amdgcn_sched_barrier(0);
            if (n == 1) {
#pragma unroll
                for (int m = 0; m < 4; ++m) {
                    const int row = pm * 256 + ai * 128 + wr * 64 + m * 16 + fr;
                    const f32x4 a0 = acc[ai][bj][m][0], a1 = acc[ai][bj][m][1];
                    st16_pair(x1b + (size_t)row * D + pn * 256 + bj * 128 + wc * 32, pk2(a0.x, a0.y), pk2(a0.z, a0.w), pk2(a1.x, a1.y), pk2(a1.z, a1.w), fq);
                }
            }
            __builtin_amdgcn_sched_barrier(0);
        }
#undef ERN_LOAD4
        } else {
        u32x4 raw[2][2][4];
#define ERN_LD16(bj_) do { _Pragma("unroll") for (int ai = 0; ai < 2; ++ai) _Pragma("unroll") for (int m = 0; m < 4; ++m) \
            raw[bj_][ai][m] = *(const u32x4*)(x1b + (size_t)(pm * 256 + ai * 128 + wr * 64 + m * 16 + fr) * D + pn * 256 + (bj_) * 128 + wc * 32 + (fq & 1) * 16 + (fq >> 1) * 8); } while (0)
#define ERN_CMP16(bj_, ai_) do { _Pragma("unroll") for (int m = 0; m < 4; ++m) { \
            const u32x4 rv = raw[bj_][ai_][m]; \
            const auto r0 = __builtin_amdgcn_permlane16_swap(rv.x, rv.z, false, false); \
            const auto r1 = __builtin_amdgcn_permlane16_swap(rv.y, rv.w, false, false); \
            const unsigned pq[2][2] = {{(unsigned)r0[0], (unsigned)r1[0]}, {(unsigned)r0[1], (unsigned)r1[1]}}; \
            _Pragma("unroll") for (int n = 0; n < 2; ++n) { \
                f32x4 a = acc[ai_][bj_][m][n]; \
                a.x = bflo(pq[n][0]) + gq[bj_][n].x * a.x; a.y = bfhi(pq[n][0]) + gq[bj_][n].y * a.y; a.z = bflo(pq[n][1]) + gq[bj_][n].z * a.z; a.w = bfhi(pq[n][1]) + gq[bj_][n].w * a.w; \
                acc[ai_][bj_][m][n] = a; \
                ss[ai_][m] += (a.x * a.x + a.y * a.y) + (a.z * a.z + a.w * a.w); } } } while (0)
        float4 gq[2][2];
#pragma unroll
        for (int bj = 0; bj < 2; ++bj)
#pragma unroll
            for (int n = 0; n < 2; ++n) gq[bj][n] = *(const float4*)(gate + b * 6144 + pn * 256 + bj * 128 + wc * 32 + n * 16 + fq * 4);
        ERN_LD16(0);
        __builtin_amdgcn_sched_barrier(0);
        ERN_CMP16(0, 0);
        __builtin_amdgcn_sched_barrier(0);
        ERN_LD16(1);
        __builtin_amdgcn_sched_barrier(0);
        ERN_CMP16(0, 1);
        __builtin_amdgcn_sched_barrier(0);
        ERN_CMP16(1, 0); ERN_CMP16(1, 1);
#undef ERN_LD16
#undef ERN_CMP16
        }
        float4 g2[4];
        if (MODE == 1) {
#pragma unroll
            for (int q = 0; q < 4; ++q) g2[q] = *(const float4*)(gain + pn * 256 + (q >> 1) * 128 + wc * 32 + (q & 1) * 16 + fq * 4);
        }
        LAS float* red = (LAS float*)lds;
        LAS float* rin = red + 1024;
#pragma unroll
        for (int ai = 0; ai < 2; ++ai)
#pragma unroll
            for (int m = 0; m < 4; ++m) {
                float v = ss[ai][m]; v += __shfl_xor(v, 16); v += __shfl_xor(v, 32);
                if (fq == 0) red[wc * 256 + ai * 128 + wr * 64 + m * 16 + fr] = v;
            }
        __syncthreads();
        if (tid < 256) {
            const float mine = (red[tid] + red[256 + tid]) + (red[512 + tid] + red[768 + tid]);
            gu64* g = (gu64*)(xch + ((size_t)pm * 4) * 256 + tid);
            __hip_atomic_store(g + pn * 256, ((unsigned long long)tag << 32) | (unsigned long long)__float_as_uint(mine), RLX_AGENT);
            float part[4];
#pragma unroll
            for (int q = 0; q < 4; ++q) {
                part[q] = mine;
                if (q != pn) {
                    unsigned spins = 0;
                    for (;;) {
                        const unsigned long long x = __hip_atomic_load(g + q * 256, RLX_AGENT);
                        if ((unsigned)(x >> 32) == tag) { part[q] = __uint_as_float((unsigned)x); break; }
                        __builtin_amdgcn_s_sleep(1);
                        if (++spins > (1u << 22)) break;
                    }
                }
            }
            const float tot = (part[0] + part[1]) + (part[2] + part[3]);
            rin[tid] = rsqrtf(tot * (1.f / D) + EPS);
        }
        __syncthreads();
        if (MODE == 0) {
#pragma unroll
            for (int bj = 0; bj < 2; ++bj) {
                float4 gq[2], shq[2];
#pragma unroll
                for (int n = 0; n < 2; ++n) {
                    const int col = pn * 256 + bj * 128 + wc * 32 + n * 16 + fq * 4;
                    gq[n] = *(const float4*)(gain + col);
                    const float4 sc = *(const float4*)(mod + b * 6144 + mo_sc + col); shq[n] = *(const float4*)(mod + b * 6144 + mo_sh + col);
                    gq[n].x *= 1.f + sc.x; gq[n].y *= 1.f + sc.y; gq[n].z *= 1.f + sc.z; gq[n].w *= 1.f + sc.w;
                }
#pragma unroll
                for (int ai = 0; ai < 2; ++ai)
#pragma unroll
                    for (int m = 0; m < 4; ++m) {
                        const int lrow = ai * 128 + wr * 64 + m * 16 + fr, row = pm * 256 + lrow;
                        const float r = rin[lrow];
                        const f32x4 a0 = acc[ai][bj][m][0], a1 = acc[ai][bj][m][1];
                        st16_pair(hout + (size_t)row * D + pn * 256 + bj * 128 + wc * 32,
                                  pk2(a0.x * r * gq[0].x + shq[0].x, a0.y * r * gq[0].y + shq[0].y), pk2(a0.z * r * gq[0].z + shq[0].z, a0.w * r * gq[0].w + shq[0].w),
                                  pk2(a1.x * r * gq[1].x + shq[1].x, a1.y * r * gq[1].y + shq[1].y), pk2(a1.z * r * gq[1].z + shq[1].z, a1.w * r * gq[1].w + shq[1].w), fq);
                    }
            }
        } else {
#pragma unroll
        for (int bj = 0; bj < 2; ++bj)
#pragma unroll
            for (int n = 0; n < 2; ++n) {
                const int col = pn * 256 + bj * 128 + wc * 32 + n * 16 + fq * 4;
                float4 g, sh = make_float4(0.f, 0.f, 0.f, 0.f);
                if (MODE == 1) g = g2[bj * 2 + n];
                else {
                    g = *(const float4*)(gain + col);
                    const float4 sc = *(const float4*)(mod + b * 6144 + mo_sc + col); sh = *(const float4*)(mod + b * 6144 + mo_sh + col);
                    g.x *= 1.f + sc.x; g.y *= 1.f + sc.y; g.z *= 1.f + sc.z; g.w *= 1.f + sc.w;
                }
#pragma unroll
                for (int ai = 0; ai < 2; ++ai)
#pragma unroll
                    for (int m = 0; m < 4; ++m) {
                        const int lrow = ai * 128 + wr * 64 + m * 16 + fr, row = pm * 256 + lrow;
                        const float r = rin[lrow];
                        const f32x4 a = acc[ai][bj][m][n];
                        if (MODE == 0) {
                            u32x2 o; o.x = pk2(a.x * r * g.x + sh.x, a.y * r * g.y + sh.y); o.y = pk2(a.z * r * g.z + sh.z, a.w * r * g.w + sh.w);
                            *(u32x2*)(hout + (size_t)row * D + col) = o;
                        } else {
                            f32x4 o; o.x = a.x * r * g.x; o.y = a.y * r * g.y; o.z = a.z * r * g.z; o.w = a.w * r * g.w;
                            *(f32x4*)(fout + (size_t)row * D + col) = o;
                        }
                    }
            }
        }
    }
};
struct EpiUp {
    u16* act; u16* side; const float* cw; const float* cb;
    __device__ __forceinline__ void operator()(LAS unsigned char* lds, const f32x4 (&acc)[2][2][4][2], int pm, int pn, u32x4 (&outv)[4], u32x4 (&sidev)[2][2]) const {
        const int tid = opaque_tid(), wid = tid >> 6, lane = tid & 63, wr = wid >> 2, wc = wid & 3, fr = lane & 15, fq = lane >> 4;
        const int cgp = tid & 15, rg = tid >> 4;
        const int ju = pn * 128 + cgp * 8;
        float wu[3][8], wv[3][8], bu[8], bv[8];
#pragma unroll
        for (int k = 0; k < 3; ++k) {
            const float4 a0 = *(const float4*)(cw + k * NUP + ju), a1 = *(const float4*)(cw + k * NUP + ju + 4);
            const float4 c0 = *(const float4*)(cw + k * NUP + DFF + ju), c1 = *(const float4*)(cw + k * NUP + DFF + ju + 4);
            wu[k][0] = a0.x; wu[k][1] = a0.y; wu[k][2] = a0.z; wu[k][3] = a0.w; wu[k][4] = a1.x; wu[k][5] = a1.y; wu[k][6] = a1.z; wu[k][7] = a1.w;
            wv[k][0] = c0.x; wv[k][1] = c0.y; wv[k][2] = c0.z; wv[k][3] = c0.w; wv[k][4] = c1.x; wv[k][5] = c1.y; wv[k][6] = c1.z; wv[k][7] = c1.w;
        }
        {   const float4 a0 = *(const float4*)(cb + ju), a1 = *(const float4*)(cb + ju + 4), c0 = *(const float4*)(cb + DFF + ju), c1 = *(const float4*)(cb + DFF + ju + 4);
            bu[0] = a0.x; bu[1] = a0.y; bu[2] = a0.z; bu[3] = a0.w; bu[4] = a1.x; bu[5] = a1.y; bu[6] = a1.z; bu[7] = a1.w;
            bv[0] = c0.x; bv[1] = c0.y; bv[2] = c0.z; bv[3] = c0.w; bv[4] = c1.x; bv[5] = c1.y; bv[6] = c1.z; bv[7] = c1.w; }
        __syncthreads();
#pragma unroll
        for (int ai = 0; ai < 2; ++ai)
#pragma unroll
            for (int m = 0; m < 4; ++m) {
                const int row = ai * 128 + wr * 64 + m * 16 + fr;
#pragma unroll
                for (int bj = 0; bj < 2; ++bj)
#pragma unroll
                    for (int n = 0; n < 2; ++n) {
                        const int col = bj * 128 + wc * 32 + n * 16 + fq * 4;
                        const f32x4 a = acc[ai][bj][m][n];
                        u32x2 o; o.x = pk2(a.x, a.y); o.y = pk2(a.z, a.w);
                        *(LAS u32x2*)(lds + row * 528 + col * 2) = o;
                    }
            }
        __syncthreads();
        float fu2[8], fu1[8], fv2[8], fv1[8];
#pragma unroll
        for (int q = 0; q < 8; ++q) { fu2[q] = 0.f; fu1[q] = 0.f; fv2[q] = 0.f; fv1[q] = 0.f; }
        if (rg > 0) {
            const u32x4 a2 = *(const LAS u32x4*)(lds + (rg * 8 - 2) * 528 + cgp * 16), b2 = *(const LAS u32x4*)(lds + (rg * 8 - 2) * 528 + 256 + cgp * 16);
            const u32x4 a1 = *(const LAS u32x4*)(lds + (rg * 8 - 1) * 528 + cgp * 16), b1 = *(const LAS u32x4*)(lds + (rg * 8 - 1) * 528 + 256 + cgp * 16);
#pragma unroll
            for (int q = 0; q < 4; ++q) {
                fu2[2 * q] = bflo(a2[q]); fu2[2 * q + 1] = bfhi(a2[q]); fv2[2 * q] = bflo(b2[q]); fv2[2 * q + 1] = bfhi(b2[q]);
                fu1[2 * q] = bflo(a1[q]); fu1[2 * q + 1] = bfhi(a1[q]); fv1[2 * q] = bflo(b1[q]); fv1[2 * q + 1] = bfhi(b1[q]);
            }
        }
#pragma unroll
        for (int rr = 0; rr < 8; ++rr) {
            const int row = rg * 8 + rr;
            const u32x4 cu = *(const LAS u32x4*)(lds + row * 528 + cgp * 16), cv = *(const LAS u32x4*)(lds + row * 528 + 256 + cgp * 16);
            float fu0[8], fv0[8];
#pragma unroll
            for (int q = 0; q < 4; ++q) { fu0[2 * q] = bflo(cu[q]); fu0[2 * q + 1] = bfhi(cu[q]); fv0[2 * q] = bflo(cv[q]); fv0[2 * q + 1] = bfhi(cv[q]); }
            {
                unsigned o[4];
#pragma unroll
                for (int q = 0; q < 4; ++q) {
                    const float gu_lo = wu[0][2 * q] * fu2[2 * q] + wu[1][2 * q] * fu1[2 * q] + wu[2][2 * q] * fu0[2 * q] + bu[2 * q];
                    const float gu_hi = wu[0][2 * q + 1] * fu2[2 * q + 1] + wu[1][2 * q + 1] * fu1[2 * q + 1] + wu[2][2 * q + 1] * fu0[2 * q + 1] + bu[2 * q + 1];
                    const float gv_lo = wv[0][2 * q] * fv2[2 * q] + wv[1][2 * q] * fv1[2 * q] + wv[2][2 * q] * fv0[2 * q] + bv[2 * q];
                    const float gv_hi = wv[0][2 * q + 1] * fv2[2 * q + 1] + wv[1][2 * q + 1] * fv1[2 * q + 1] + wv[2][2 * q + 1] * fv0[2 * q + 1] + bv[2 * q + 1];
                    o[q] = pk2(siluf_(gu_lo) * gv_lo, siluf_(gu_hi) * gv_hi);
                }
                if (rr < 4) { if (row >= 2) st16_wt(act, (unsigned)(((size_t)(pm * 256 + row) * DFF + ju) * 2), (u32x4){o[0], o[1], o[2], o[3]}); }
                else outv[rr - 4] = (u32x4){o[0], o[1], o[2], o[3]};
            }
            if (rr < 2 && rg == 0) { u16* sp = side + ((size_t)pm * 4 + rr) * NUP + pn * 256 + cgp * 8; *(u32x4*)sp = cu; *(u32x4*)(sp + 128) = cv; }
            if (rr >= 6) { sidev[rr & 1][0] = cu; sidev[rr & 1][1] = cv; }
#pragma unroll
            for (int q = 0; q < 8; ++q) { fu2[q] = fu1[q]; fu1[q] = fu0[q]; fv2[q] = fv1[q]; fv1[q] = fv0[q]; }
        }
        __syncthreads();
    }
    __device__ __forceinline__ void flush(int pm, int pn, const u32x4 (&outv)[4], const u32x4 (&sidev)[2][2]) const {
        const int tid = opaque_tid(), cgp = tid & 15, rg = tid >> 4, ju = pn * 128 + cgp * 8;
#pragma unroll
        for (int rr = 4; rr < 8; ++rr) { const int row = rg * 8 + rr; st16_wt(act, (unsigned)(((size_t)(pm * 256 + row) * DFF + ju) * 2), outv[rr - 4]); }
        if (rg == 31) {
#pragma unroll
            for (int k = 0; k < 2; ++k) { u16* sp = side + ((size_t)pm * 4 + 2 + k) * NUP + pn * 256 + cgp * 8; *(u32x4*)sp = sidev[k][0]; *(u32x4*)(sp + 128) = sidev[k][1]; }
        }
    }
};

template <class Epi>
__device__ __forceinline__ void gemm_phase_stream(LAS unsigned char* lds, const u16* A, const u16* Bt, int N, int K, const Epi& E) {
    const int nM = MTOK / 256, nN = N / 256, ntiles = nM * nN;
    int t0 = blockIdx.x;
    if (t0 >= ntiles) return;
    const int tid = opaque_tid(), wid = __builtin_amdgcn_readfirstlane(tid >> 6), lane = tid & 63, wr = wid >> 2, wc = wid & 3, fr = lane & 15, fq = lane >> 4;
    const int nt = K / BK;
    unsigned voff[2];
#pragma unroll
    for (int i = 0; i < 2; ++i) { int R, C; stage_rc(tid * 16 + i * 8192, R, C); voff[i] = (unsigned)(R * K + C) * 2u; }
    const size_t kstep = (size_t)(BK * 2);
    const size_t hstep = (size_t)HALF * K * 2;
    const size_t tstep = 2 * hstep;
    const unsigned ldsw = (unsigned)wid * 1024u;
    const int aoff = lds_byte(wr * 64 + fr, fq * 8), boff = lds_byte(wc * 32 + fr, fq * 8);
    f32x4 acc[2][2][4][2];
    bf16x8 At[4][2], B0[2][2], B1[2][2];
    const char* cA = (const char*)A + (size_t)(t0 % nM) * tstep; const char* cB = (const char*)Bt + (size_t)(t0 / nM) * tstep;
    G_WAIT_V(0);
    __syncthreads();
    G_STAGE(G_SB(0, 0), cB, voff); G_STAGE(G_SB(0, 1), cB + hstep, voff); G_STAGE(G_SA(0, 0), cA, voff); G_STAGE(G_SA(0, 1), cA + hstep, voff);
    if (wr == 1) G_BAR;
    G_WAIT_V(2); G_BAR;
    G_STAGE(G_SB(1, 0), cB + kstep, voff); G_STAGE(G_SA(1, 0), cA + kstep, voff); G_STAGE(G_SB(1, 1), cB + hstep + kstep, voff);
    G_WAIT_V(6); G_BAR;
    for (int tcur = t0; tcur < ntiles; tcur += gridDim.x) {
        const int tnext = tcur + (int)gridDim.x;
        const bool has_next = tnext < ntiles;
        const char* nA = has_next ? (const char*)A + (size_t)(tnext % nM) * tstep : cA; const char* nB = has_next ? (const char*)Bt + (size_t)(tnext / nM) * tstep : cB;
#pragma unroll
        for (int a = 0; a < 2; ++a)
#pragma unroll
            for (int b = 0; b < 2; ++b)
#pragma unroll
                for (int m = 0; m < 4; ++m)
#pragma unroll
                    for (int n = 0; n < 2; ++n) acc[a][b][m][n] = (f32x4){0.f, 0.f, 0.f, 0.f};
        for (int t = 0; t < nt; t += 2) {
            const bool last = (t == nt - 2);
            const char* a1 = cA + (size_t)(t + 1) * kstep;
            const char* a2 = last ? nA : cA + (size_t)(t + 2) * kstep; const char* b2 = last ? nB : cB + (size_t)(t + 2) * kstep;
            const char* a3 = a2 + kstep; const char* b3 = b2 + kstep;
            G_LDB(B0, 0, 0); G_LDB(B1, 0, 1); G_SCHED; G_LDA(At, 0, 0); G_STAGE(G_SA(1, 1), a1 + hstep, voff);
            G_WAIT_V(8); G_WAIT_L(0); G_BAR; G_MMA(0, 0, At, B0); G_MMA(0, 1, At, B1); G_BAR; G_SCHED;
            G_LDA(At, 0, 1); G_STAGE(G_SB(0, 0), b2, voff); G_STAGE(G_SB(0, 1), b2 + hstep, voff); G_STAGE(G_SA(0, 0), a2, voff);
            G_WAIT_V(8); G_WAIT_L(0); G_BAR; G_MMA(1, 0, At, B0); G_MMA(1, 1, At, B1); G_BAR; G_SCHED;
            G_LDB(B0, 1, 0); G_LDB(B1, 1, 1); G_SCHED; G_LDA(At, 1, 0); G_STAGE(G_SA(0, 1), a2 + hstep, voff);
            G_WAIT_V(8); G_WAIT_L(0); G_BAR; G_MMA(0, 0, At, B0); G_MMA(0, 1, At, B1); G_BAR; G_SCHED;
            G_LDA(At, 1, 1); G_STAGE(G_SB(1, 0), b3, voff); G_STAGE(G_SB(1, 1), b3 + hstep, voff); G_STAGE(G_SA(1, 0), a3, voff);
            G_WAIT_V(8); G_WAIT_L(0); G_BAR; G_MMA(1, 0, At, B0); G_MMA(1, 1, At, B1); G_BAR; G_SCHED;
        }
        E(lds, acc, tcur % nM, tcur / nM);
        cA = nA; cB = nB;
    }
    G_WAIT_V(0);
    if (wr == 0) G_BAR;
    G_BAR;
}

__device__ __forceinline__ void gemm_phase_up(LAS unsigned char* lds, const u16* A, const u16* Bt, int N, int K, const EpiUp& E) {
    const int nM = MTOK / 256, nN = N / 256, ntiles = nM * nN;
    u32x4 outv[4], sidev[2][2];
#pragma unroll
    for (int i = 0; i < 4; ++i) outv[i] = (u32x4){0u, 0u, 0u, 0u};
#pragma unroll
    for (int i = 0; i < 2; ++i) { sidev[i][0] = (u32x4){0u, 0u, 0u, 0u}; sidev[i][1] = (u32x4){0u, 0u, 0u, 0u}; }
    int ppm = 0, ppn = 0; bool has = false;
    for (int t = blockIdx.x; t < ntiles; t += gridDim.x) {
        const int pm = t % nM, pn = t / nM;
        f32x4 acc[2][2][4][2];
        gemm_tile(lds, (const char*)(A + (size_t)pm * 256 * K), (const char*)(Bt + (size_t)pn * 256 * K), K, acc, has, [&] { E.flush(ppm, ppn, outv, sidev); });
        E(lds, acc, pm, pn, outv, sidev);
        ppm = pm; ppn = pn; has = true;
    }
    if (has) E.flush(ppm, ppn, outv, sidev);
}
template <class Epi>
__device__ __forceinline__ void gemm_phase(LAS unsigned char* lds, const u16* A, const u16* Bt, int N, int K, const Epi& E) {
    const int nM = MTOK / 256, nN = N / 256, ntiles = nM * nN;
    for (int t = blockIdx.x; t < ntiles; t += gridDim.x) {
        const int pm = t % nM, pn = t / nM;
        f32x4 acc[2][2][4][2];
        gemm_tile(lds, (const char*)(A + (size_t)pm * 256 * K), (const char*)(Bt + (size_t)pn * 256 * K), K, acc, false, [] {});
        E(lds, acc, pm, pn);
    }
}

__device__ __forceinline__ void transpose_tile(LAS float* T, const float* W, int K, int N, u16* WT, int kt, int ntl, bool perm_up) {
    const int tid = opaque_tid(), k0 = kt * 64, n0 = ntl * 128;
    const int r = tid >> 5, c4 = tid & 31;
#pragma unroll
    for (int pass = 0; pass < 4; ++pass) {
        const int kk = pass * 16 + r;
        const float4 v = *(const float4*)(W + (size_t)(k0 + kk) * N + n0 + c4 * 4);
        LAS float* t = T + kk * 129 + c4 * 4;
        t[0] = v.x; t[1] = v.y; t[2] = v.z; t[3] = v.w;
    }
    __syncthreads();
    const int n = tid >> 2, kq = tid & 3;
    unsigned o[8];
#pragma unroll
    for (int i = 0; i < 8; ++i) o[i] = pk2(T[(kq * 16 + 2 * i) * 129 + n], T[(kq * 16 + 2 * i + 1) * 129 + n]);
    int nrow = n0 + n;
    if (perm_up) { const int j = nrow < DFF ? nrow : nrow - DFF; nrow = (j >> 7) * 256 + (nrow < DFF ? 0 : 128) + (j & 127); }
    uint4* dst = (uint4*)(WT + (size_t)nrow * K + k0 + kq * 16);
    dst[0] = make_uint4(o[0], o[1], o[2], o[3]); dst[1] = make_uint4(o[4], o[5], o[6], o[7]);
    __syncthreads();
}

__device__ __forceinline__ void phase_prep(const Params& p, LAS unsigned char* lds) {
    const int tid = opaque_tid(), wave = tid >> 6, lane = tid & 63;
    constexpr int T_ADA = 192, T_MISC = 1;
    constexpr int T_WIN = (D / 64) * (DIN / 128);
    constexpr int NT = T_ADA + T_MISC + T_WIN;
    float* mod = (float*)(p.ws + OFF_MOD);
    for (int it = blockIdx.x; it < NT; it += gridDim.x) {
        int r = it;
        if (r < T_ADA) {
            const int cgp = r >> 1, kh = r & 1;
            LAS float* sc = (LAS float*)lds;
            LAS float* red = sc + 4096;
            for (int i = tid; i < 4096; i += NTHREADS) { const int b = i >> 9, k = i & 511; sc[i] = siluf_(p.c[b * 1024 + kh * 512 + k]); }
            __syncthreads();
            const int col = cgp * 64 + lane;
            float a[8] = {0.f, 0.f, 0.f, 0.f, 0.f, 0.f, 0.f, 0.f};
            const float* wp = p.ada_w + (size_t)(kh * 512 + wave * 64) * 6144 + col;
#pragma unroll 16
            for (int k = 0; k < 64; ++k) {
                const float wv = wp[(size_t)k * 6144];
#pragma unroll
                for (int b = 0; b < 8; ++b) a[b] += sc[b * 512 + wave * 64 + k] * wv;
            }
#pragma unroll
            for (int b = 0; b < 8; ++b) red[(wave * 8 + b) * 64 + lane] = a[b];
            __syncthreads();
            {   const int b = wave; float s2 = 0.f;
#pragma unroll
                for (int w = 0; w < 8; ++w) s2 += red[(w * 8 + b) * 64 + lane];
                if (kh == 0) s2 += p.ada_b[col];
                atomicAdd(&mod[b * 6144 + col], s2); }
            __syncthreads();
            continue;
        }
        r -= T_ADA;
        if (r < T_MISC) {
            u16* wat = (u16*)(p.ws + OFF_WAT); u16* wxt = (u16*)(p.ws + OFF_WXT);
            for (int i = tid; i < 8 * 64 * 64; i += NTHREADS) {
                const int blk = i >> 12, co = (i >> 6) & 63, ci = i & 63;
                const float a = p.rg_wa[(blk * 64 + ci) * 64 + co], x = p.rg_wx[(blk * 64 + ci) * 64 + co];
                wat[i] = (u16)(pk2(a, 0.f) & 0xffff); wxt[i] = (u16)(pk2(x, 0.f) & 0xffff);
            }
            float* lsl = (float*)(p.ws + OFF_LSL);
            if (tid < 512) { const float l = p.rg_lambda[tid]; lsl[tid] = fminf(l, 0.f) - __logf(1.f + __expf(-fabsf(l)));   }
            continue;
        }
        r -= T_MISC;
        LAS float* T = (LAS float*)lds;
        transpose_tile(T, p.w_in, D, DIN, (u16*)(p.ws + OFF_WIN), r / (DIN / 128), r % (DIN / 128), false);
    }
}
struct TrItem { const float* W; u16* WT; int K, N, kt, ntl, perm; };
__device__ __forceinline__ TrItem prep2_item(const Params& p, int it) {
    constexpr int T_WUP = (D / 64) * (NUP / 128), T_WOUT = (D / 64) * (D / 128);
    TrItem t; int r = it;
    if (r < T_WOUT) { t.W = p.w_out; t.WT = (u16*)(p.ws + OFF_WOUT); t.K = D; t.N = D; t.kt = r / (D / 128); t.ntl = r % (D / 128); t.perm = 0; return t; }
    r -= T_WOUT;
    if (r < T_WUP) { t.W = p.w_up; t.WT = (u16*)(p.ws + OFF_WUP); t.K = D; t.N = NUP; t.kt = r / (NUP / 128); t.ntl = r % (NUP / 128); t.perm = 1; return t; }
    r -= T_WUP;
    t.W = p.w_down; t.WT = (u16*)(p.ws + OFF_WDN); t.K = DFF; t.N = D; t.kt = r / (D / 128); t.ntl = r % (D / 128); t.perm = 0; return t;
}
__device__ __forceinline__ void prep2_load(const TrItem& t, int tid, float4 (&v)[4]) {
    const int r = tid >> 5, c4 = tid & 31;
#pragma unroll
    for (int pass = 0; pass < 4; ++pass) v[pass] = *(const float4*)(t.W + (size_t)(t.kt * 64 + pass * 16 + r) * t.N + t.ntl * 128 + c4 * 4);
}
__device__ __forceinline__ void phase_prep2(const Params& p, LAS unsigned char* lds, int first) {
    constexpr int T_WUP = (D / 64) * (NUP / 128), T_WDN = (DFF / 64) * (D / 128), T_WOUT = (D / 64) * (D / 128);
    constexpr int NIT = T_WOUT + T_WUP + T_WDN;
    LAS float* T = (LAS float*)lds;
    const int nb = (int)gridDim.x - first;
    if ((int)blockIdx.x < first || nb <= 0) return;
    const int tid = opaque_tid();
    int it = (int)blockIdx.x - first;
    if (it >= NIT) return;
    TrItem cur = prep2_item(p, it);
    float4 v[4];
    prep2_load(cur, tid, v);
    __syncthreads();
    for (; it < NIT; it += nb) {
        const int r = tid >> 5, c4 = tid & 31;
#pragma unroll
        for (int pass = 0; pass < 4; ++pass) { LAS float* t = T + (pass * 16 + r) * 129 + c4 * 4; t[0] = v[pass].x; t[1] = v[pass].y; t[2] = v[pass].z; t[3] = v[pass].w; }
        __syncthreads();
        const bool has_next = it + nb < NIT;
        TrItem nxt = cur;
        if (has_next) { nxt = prep2_item(p, it + nb); prep2_load(nxt, tid, v); }
        const int n = tid >> 2, kq = tid & 3;
        unsigned o[8];
#pragma unroll
        for (int i = 0; i < 8; ++i) o[i] = pk2(T[(kq * 16 + 2 * i) * 129 + n], T[(kq * 16 + 2 * i + 1) * 129 + n]);
        int nrow = cur.ntl * 128 + n;
        if (cur.perm) { const int j = nrow < DFF ? nrow : nrow - DFF; nrow = (j >> 7) * 256 + (nrow < DFF ? 0 : 128) + (j & 127); }
        uint4* dst = (uint4*)(cur.WT + (size_t)nrow * cur.K + cur.kt * 64 + kq * 16);
        dst[0] = make_uint4(o[0], o[1], o[2], o[3]); dst[1] = make_uint4(o[4], o[5], o[6], o[7]);
        __syncthreads();
        cur = nxt;
    }
}

template <int MODE>
__device__ __forceinline__ void phase_norm(const float* src, const float* gain, const float* mod, int mo_sh, int mo_sc, u16* dst_bf, float* dst_f) {
    const int tid = opaque_tid(), wave = tid >> 6, lane = tid & 63;
    const int stride = gridDim.x * 16;
    int row0 = (blockIdx.x * 8 + wave) * 2;
    float4 v[2][4], vn[2][4];
    if (row0 < MTOK) {
#pragma unroll
        for (int q = 0; q < 2; ++q) {
            const float4* xr = (const float4*)(src + (size_t)(row0 + q) * D) + lane;
#pragma unroll
            for (int j = 0; j < 4; ++j) v[q][j] = xr[64 * j];
        }
    }
    for (; row0 < MTOK; row0 += stride) {
        const int rown = row0 + stride;
        if (rown < MTOK) {
#pragma unroll
            for (int q = 0; q < 2; ++q) {
                const float4* xr = (const float4*)(src + (size_t)(rown + q) * D) + lane;
#pragma unroll
                for (int j = 0; j < 4; ++j) vn[q][j] = xr[64 * j];
            }
        }
        float ss[2];
#pragma unroll
        for (int q = 0; q < 2; ++q) {
            float a = 0.f;
#pragma unroll
            for (int j = 0; j < 4; ++j) a += (v[q][j].x * v[q][j].x + v[q][j].y * v[q][j].y) + (v[q][j].z * v[q][j].z + v[q][j].w * v[q][j].w);
            ss[q] = wave_sum(a);
        }
        const int b = row0 / SEQ;
#pragma unroll
        for (int j = 0; j < 4; ++j) {
            const int col = (lane + 64 * j) * 4;
            float4 g = *(const float4*)(gain + col);
            float4 sh = make_float4(0.f, 0.f, 0.f, 0.f);
            if (MODE == 0) {
                const float4 sc = *(const float4*)(mod + b * 6144 + mo_sc + col); sh = *(const float4*)(mod + b * 6144 + mo_sh + col);
                g.x *= 1.f + sc.x; g.y *= 1.f + sc.y; g.z *= 1.f + sc.z; g.w *= 1.f + sc.w;
            }
#pragma unroll
            for (int q = 0; q < 2; ++q) {
                const float rinv = rsqrtf(ss[q] * (1.f / D) + EPS);
                const float y0 = v[q][j].x * rinv * g.x + sh.x, y1 = v[q][j].y * rinv * g.y + sh.y, y2 = v[q][j].z * rinv * g.z + sh.z, y3 = v[q][j].w * rinv * g.w + sh.w;
                if (MODE == 0) { uint2 o; o.x = pk2(y0, y1); o.y = pk2(y2, y3); *(uint2*)(dst_bf + (size_t)(row0 + q) * D + col) = o; }
                else *(float4*)(dst_f + (size_t)(row0 + q) * D + col) = make_float4(y0, y1, y2, y3);
            }
        }
#pragma unroll
        for (int q = 0; q < 2; ++q)
#pragma unroll
            for (int j = 0; j < 4; ++j) v[q][j] = vn[q][j];
    }
}

typedef float f32x16 __attribute__((ext_vector_type(16)));
__device__ __forceinline__ void phase_attn(const Params& p, LAS unsigned char* lds) {
    const int tid = opaque_tid(), h = tid >> 6, lane = tid & 63, l31 = lane & 31, g = lane >> 5;
    const u16* proj = (const u16*)(p.ws + OFF_PROJ);
    const u16* Vt = (const u16*)(p.ws + OFF_VT);
    const u16* Kf = (const u16*)(p.ws + OFF_KF);
    u16* ymix = (u16*)(p.ws + OFF_YMIX);
    const float L2E = 1.4426950408889634f;
    LAS float* Bs = (LAS float*)lds;
    __syncthreads();
    for (int i = tid; i < 8 * 257; i += NTHREADS) { const int hh = i / 257, j = i - hh * 257; Bs[hh * 260 + j] = p.rel_bias[i] * L2E; }
    __syncthreads();
    const LAS float* Bh = Bs + h * 260;
    const float bconst = Bh[256];
    for (int task = blockIdx.x; task < BATCH * 32; task += gridDim.x) {
        int n = task & 31, b = task >> 5;
        if (gridDim.x == 256) { b = task & 7; n = task >> 3; }
        const size_t tok0 = (size_t)b * SEQ + n * 64;
        LAS unsigned char* Qs = lds + 16384 + (tid >> 6) * 8192 + lane * 16;
#pragma unroll
        for (int hf = 0; hf < 2; ++hf)
#pragma unroll
            for (int ks = 0; ks < 4; ++ks) {
                const bf16x8 qv = *(const bf16x8*)(proj + (tok0 + hf * 32 + l31) * PST + C_Q + h * 64 + ks * 16 + g * 8);
                *(LAS bf16x8*)(Qs + (hf * 4 + ks) * 1024) = qv;
            }
        f32x16 o[2][2];
#pragma unroll
        for (int hf = 0; hf < 2; ++hf)
#pragma unroll
            for (int db = 0; db < 2; ++db)
#pragma unroll
                for (int i = 0; i < 16; ++i) o[hf][db][i] = 0.f;
        float mrun[2] = {-INFINITY, -INFINITY}, lrun[2] = {0.f, 0.f};
        const int cstart = n >= 8 ? 0 : 8 - n;
        const int hu = __builtin_amdgcn_readfirstlane(h);
        const u16* kbase = Kf + (size_t)(b * 8 + hu) * 64 * 2048 + lane * 8;
        const u16* vbase = Vt + (size_t)(b * 8 + hu) * 128 * 1024 + lane * 8;
        bf16x8 kf[2][4], vf[2][2][2];
        {   const int key0 = (n - 8 + cstart) * 64;
#pragma unroll
            for (int kb = 0; kb < 2; ++kb)
#pragma unroll
                for (int ks = 0; ks < 4; ++ks) kf[kb][ks] = *(const bf16x8*)(kbase + (((key0 >> 5) + kb) * 4 + ks) * 512);
#pragma unroll
            for (int db = 0; db < 2; ++db)
#pragma unroll
                for (int kb = 0; kb < 2; ++kb)
#pragma unroll
                    for (int u = 0; u < 2; ++u) vf[db][kb][u] = *(const bf16x8*)(vbase + ((((key0 >> 4) + kb * 2 + u) * 2 + db) * 512));
        }
        for (int c = cstart; c <= 8; ++c) {
            const bool cb = c <= 5;
            const int t2 = opaque_tid(), l31c = t2 & 31, gc = (t2 >> 5) & 1; const unsigned lo8 = (unsigned)(t2 & 63) * 8u;
            const u16* kb2 = Kf + (size_t)(b * 8 + hu) * 64 * 2048; const u16* vb2 = Vt + (size_t)(b * 8 + hu) * 128 * 1024;
#pragma unroll
            for (int hf = 0; hf < 2; ++hf) {
                __builtin_amdgcn_sched_barrier(0);
                f32x16 s_[2];
                bf16x8 qf[4];
#pragma unroll
                for (int ks = 0; ks < 4; ++ks) qf[ks] = *(const LAS bf16x8*)(lds + 16384 + (t2 >> 6) * 8192 + (t2 & 63) * 16 + (hf * 4 + ks) * 1024);
#pragma unroll
                for (int kb = 0; kb < 2; ++kb) {
#pragma unroll
                    for (int i = 0; i < 16; ++i) s_[kb][i] = 0.f;
#pragma unroll
                    for (int ks = 0; ks < 4; ++ks) s_[kb] = __builtin_amdgcn_mfma_f32_32x32x16_bf16(kf[kb][ks], qf[ks], s_[kb], 0, 0, 0);
                }
                if (hf == 1 && c < 8) {
                    const int key0 = (n - 8 + c + 1) * 64;
#pragma unroll
                    for (int kb = 0; kb < 2; ++kb)
#pragma unroll
                        for (int ks = 0; ks < 4; ++ks) kf[kb][ks] = *(const bf16x8*)(kb2 + (unsigned)((((key0 >> 5) + kb) * 4 + ks) * 512) + lo8);
                }
                float mx = -INFINITY;
                if (cb) {
#pragma unroll
                    for (int kb = 0; kb < 2; ++kb)
#pragma unroll
                        for (int i = 0; i < 16; ++i) mx = fmaxf(mx, s_[kb][i]);
                    mx = mx * (0.125f * L2E) + bconst;
                } else {
                    const int relb = 512 + hf * 32 + l31c - c * 64 - 4 * gc + 128;
#pragma unroll
                    for (int kb = 0; kb < 2; ++kb)
#pragma unroll
                        for (int i = 0; i < 16; ++i) {
                            int idx = relb - (kb * 32 + 8 * (i >> 2) + (i & 3));
                            idx = idx < 0 ? 0 : (idx > 256 ? 256 : idx);
                            const float v = s_[kb][i] * (0.125f * L2E) + Bh[idx]; s_[kb][i] = v; mx = fmaxf(mx, v);
                        }
                }
                mx = fmaxf(mx, __shfl_xor(mx, 32));
                const float mnew = fmaxf(mrun[hf], mx);
                const float alpha = __builtin_amdgcn_exp2f(mrun[hf] - mnew);
                mrun[hf] = mnew;
                float ls = 0.f;
                if (cb) {
                    const float off = bconst - mnew;
#pragma unroll
                    for (int kb = 0; kb < 2; ++kb)
#pragma unroll
                        for (int i = 0; i < 16; ++i) { const float pv = __builtin_amdgcn_exp2f(s_[kb][i] * (0.125f * L2E) + off); s_[kb][i] = pv; ls += pv; }
                } else {
#pragma unroll
                    for (int kb = 0; kb < 2; ++kb)
#pragma unroll
                        for (int i = 0; i < 16; ++i) { const float pv = __builtin_amdgcn_exp2f(s_[kb][i] - mnew); s_[kb][i] = pv; ls += pv; }
                }
                lrun[hf] = lrun[hf] * alpha + ls;
#pragma unroll
                for (int db = 0; db < 2; ++db)
#pragma unroll
                    for (int i = 0; i < 16; ++i) o[hf][db][i] *= alpha;
#pragma unroll
                for (int kb = 0; kb < 2; ++kb)
#pragma unroll
                    for (int u = 0; u < 2; ++u) {
                        union { bf16x8 v; unsigned w[4]; } pf;
                        pf.w[0] = pk2(s_[kb][8 * u + 0], s_[kb][8 * u + 1]); pf.w[1] = pk2(s_[kb][8 * u + 2], s_[kb][8 * u + 3]);
                        pf.w[2] = pk2(s_[kb][8 * u + 4], s_[kb][8 * u + 5]); pf.w[3] = pk2(s_[kb][8 * u + 6], s_[kb][8 * u + 7]);
#pragma unroll
                        for (int db = 0; db < 2; ++db) o[hf][db] = __builtin_amdgcn_mfma_f32_32x32x16_bf16(vf[db][kb][u], pf.v, o[hf][db], 0, 0, 0);
                    }
            }
            if (c < 8) {
                const int key0 = (n - 8 + c + 1) * 64;
#pragma unroll
                for (int db = 0; db < 2; ++db)
#pragma unroll
                    for (int kb = 0; kb < 2; ++kb)
#pragma unroll
                        for (int u = 0; u < 2; ++u) vf[db][kb][u] = *(const bf16x8*)(vb2 + (unsigned)((((key0 >> 4) + kb * 2 + u) * 2 + db) * 512) + lo8);
            }
        }
#pragma unroll
        for (int hf = 0; hf < 2; ++hf) {
            float lr = lrun[hf]; lr += __shfl_xor(lr, 32);
            const float inv = __builtin_amdgcn_rcpf(lr);
#pragma unroll
            for (int db = 0; db < 2; ++db)
#pragma unroll
                for (int k = 0; k < 4; k += 2) {
                    const unsigned a0 = pk2(o[hf][db][4 * k] * inv, o[hf][db][4 * k + 1] * inv), a1 = pk2(o[hf][db][4 * k + 2] * inv, o[hf][db][4 * k + 3] * inv);
                    const unsigned b0 = pk2(o[hf][db][4 * k + 4] * inv, o[hf][db][4 * k + 5] * inv), b1 = pk2(o[hf][db][4 * k + 6] * inv, o[hf][db][4 * k + 7] * inv);
                    const auto r0 = __builtin_amdgcn_permlane32_swap(a0, b0, false, false);
                    const auto r1 = __builtin_amdgcn_permlane32_swap(a1, b1, false, false);
                    *(u32x4*)(ymix + (tok0 + hf * 32 + l31) * D + DRNN + h * 64 + db * 32 + 8 * (k + g)) = (u32x4){(unsigned)r0[0], (unsigned)r1[0], (unsigned)r0[1], (unsigned)r1[1]};
                }
        }
    }
}

__device__ __forceinline__ void phase_rnn(const Params& p, LAS unsigned char* lds) {
    const int tid = opaque_tid(), wave = tid >> 6, lane = tid & 63, fr = lane & 15, fq = lane >> 4;
    const u16* proj = (const u16*)(p.ws + OFF_PROJ);
    const u16* wat = (const u16*)(p.ws + OFF_WAT); const u16* wxt = (const u16*)(p.ws + OFF_WXT);
    const float* lsl = (const float*)(p.ws + OFF_LSL);
    gu64* RT = (gu64*)(p.ws + OFF_RTOT);
    u16* ymix = (u16*)(p.ws + OFF_YMIX);
    LAS unsigned char* Xb = lds;
    LAS float* Xf = (LAS float*)(lds + 64 * 144);
    LAS float* Gt = Xf + 64 * 64;
    LAS float* Sg = Gt + 2 * 64 * 64;
    LAS float* Pt = Sg + 8 * 64 * 2;
    const int ctok = tid >> 3, cq = tid & 7;
    uint4 xv[4];
    const int NTASK = BATCH * 32 * 8;
    if ((int)blockIdx.x < NTASK) {
        const int task = blockIdx.x, nb = task & 7, b = (task >> 3) & 7, tt = task >> 6;
#pragma unroll
        for (int k = 0; k < 4; ++k) {
            const int ts = tt * 64 + ctok - 3 + k;
            xv[k] = ts >= 0 ? *(const uint4*)(proj + ((size_t)b * SEQ + ts) * PST + C_XR + nb * 64 + cq * 8) : make_uint4(0, 0, 0, 0);
        }
    }
    int cur_nb = -1;
    float cw[4][8], cbias[8], ba = 0.f, bx = 0.f, ll = 0.f;
    bf16x8 wfr[4][2];
    const int sel = wave & 1, mt = wave >> 1;
    for (int task = blockIdx.x; task < NTASK; task += gridDim.x) {
        const int nb = task & 7, b = (task >> 3) & 7, tt = task >> 6;
        if (nb != cur_nb) {
            cur_nb = nb;
            const int chc = nb * 64 + cq * 8;
            {   const float4 b0 = *(const float4*)(p.rnn_conv_b + chc), b1 = *(const float4*)(p.rnn_conv_b + chc + 4);
                cbias[0] = b0.x; cbias[1] = b0.y; cbias[2] = b0.z; cbias[3] = b0.w; cbias[4] = b1.x; cbias[5] = b1.y; cbias[6] = b1.z; cbias[7] = b1.w; }
#pragma unroll
            for (int k = 0; k < 4; ++k) {
                const float4 w0 = *(const float4*)(p.rnn_conv_w + k * DRNN + chc), w1 = *(const float4*)(p.rnn_conv_w + k * DRNN + chc + 4);
                cw[k][0] = w0.x; cw[k][1] = w0.y; cw[k][2] = w0.z; cw[k][3] = w0.w; cw[k][4] = w1.x; cw[k][5] = w1.y; cw[k][6] = w1.z; cw[k][7] = w1.w;
            }
            const int chl = nb * 64 + lane;
            ba = p.rg_ba[chl]; bx = p.rg_bx[chl]; ll = lsl[chl];
            const u16* wT = (sel ? wxt : wat) + nb * 4096;
#pragma unroll
            for (int nt = 0; nt < 4; ++nt)
#pragma unroll
                for (int ks = 0; ks < 2; ++ks) wfr[nt][ks] = *(const bf16x8*)(wT + (nt * 16 + fr) * 64 + ks * 32 + fq * 8);
        }
        __syncthreads();
        {   float xc[8];
#pragma unroll
            for (int j = 0; j < 8; ++j) xc[j] = cbias[j];
#pragma unroll
            for (int k = 0; k < 4; ++k) {
                xc[0] += cw[k][0] * bflo(xv[k].x); xc[1] += cw[k][1] * bfhi(xv[k].x); xc[2] += cw[k][2] * bflo(xv[k].y); xc[3] += cw[k][3] * bfhi(xv[k].y);
                xc[4] += cw[k][4] * bflo(xv[k].z); xc[5] += cw[k][5] * bfhi(xv[k].z); xc[6] += cw[k][6] * bflo(xv[k].w); xc[7] += cw[k][7] * bfhi(xv[k].w);
            }
            *(LAS u32x4*)(Xb + ctok * 144 + cq * 16) = (u32x4){pk2(xc[0], xc[1]), pk2(xc[2], xc[3]), pk2(xc[4], xc[5]), pk2(xc[6], xc[7])};
            LAS f32x4* xf = (LAS f32x4*)(Xf + ctok * 64 + cq * 8);
            xf[0] = (f32x4){xc[0], xc[1], xc[2], xc[3]}; xf[1] = (f32x4){xc[4], xc[5], xc[6], xc[7]};
        }
        {
            const int nt_ = task + (int)gridDim.x;
            if (nt_ < NTASK) {
                const int nb2 = nt_ & 7, b2 = (nt_ >> 3) & 7, tt2 = nt_ >> 6;
#pragma unroll
                for (int k = 0; k < 4; ++k) {
                    const int ts = tt2 * 64 + ctok - 3 + k;
                    xv[k] = ts >= 0 ? *(const uint4*)(proj + ((size_t)b2 * SEQ + ts) * PST + C_XR + nb2 * 64 + cq * 8) : make_uint4(0, 0, 0, 0);
                }
            }
        }
        const int ch = nb * 64 + lane;
        const size_t tokb = (size_t)b * SEQ + tt * 64 + wave * 8;
        u16 gr[8];
#pragma unroll
        for (int i = 0; i < 8; ++i) gr[i] = proj[(tokb + i) * PST + C_GR + ch];
        unsigned long long pg[4];
#pragma unroll
        for (int j = 0; j < 4; ++j) { const int s2 = wave + 8 * j; pg[j] = s2 < tt ? __hip_atomic_load(RT + ((size_t)(b * 32 + s2) * DRNN + ch), RLX_AGENT) : 1ull; }
        __syncthreads();
        {
            bf16x8 af[2];
#pragma unroll
            for (int ks = 0; ks < 2; ++ks) af[ks] = *(const LAS bf16x8*)(Xb + (mt * 16 + fr) * 144 + ks * 64 + fq * 16);
#pragma unroll
            for (int nt = 0; nt < 4; ++nt) {
                f32x4 d = (f32x4){0.f, 0.f, 0.f, 0.f};
#pragma unroll
                for (int ks = 0; ks < 2; ++ks) d = __builtin_amdgcn_mfma_f32_16x16x32_bf16(af[ks], wfr[nt][ks], d, 0, 0, 0);
#pragma unroll
                for (int r = 0; r < 4; ++r) Gt[(sel * 64 + mt * 16 + fq * 4 + r) * 64 + nt * 16 + fr] = d[r];
            }
        }
        __syncthreads();
        float acum[8], hloc[8];
        {   float A = 1.f, H = 0.f;
#pragma unroll
            for (int i = 0; i < 8; ++i) {
                const int tok = wave * 8 + i;
                const float r = sigmoidf_(Gt[tok * 64 + lane] + ba), ig = sigmoidf_(Gt[(64 + tok) * 64 + lane] + bx);
                const float a = __expf(8.f * r * ll);
                const float mult = __builtin_amdgcn_sqrtf(fmaxf(1.f - a * a, 0.f));
                const float bt = mult * (ig * Xf[tok * 64 + lane]);
                H = a * H + bt; A = A * a;
                acum[i] = A; hloc[i] = H;
            }
            Sg[(wave * 64 + lane) * 2] = A; Sg[(wave * 64 + lane) * 2 + 1] = H;
        }
        __syncthreads();
        {   float Ain = 1.f, Hin = 0.f;
            for (int s2 = 0; s2 < wave; ++s2) { const float as = Sg[(s2 * 64 + lane) * 2], hs = Sg[(s2 * 64 + lane) * 2 + 1]; Hin = as * Hin + hs; Ain *= as; }
#pragma unroll
            for (int i = 0; i < 8; ++i) { hloc[i] += acum[i] * Hin; acum[i] *= Ain; }
        }
        if (wave == 7) {
            const unsigned long long gv = ((unsigned long long)__float_as_uint(hloc[7]) << 32) | (unsigned long long)(__float_as_uint(acum[7]) | 1u);
            __hip_atomic_store(RT + ((size_t)(b * 32 + tt) * DRNN + ch), gv, RLX_AGENT);
        }
#pragma unroll
        for (int j = 0; j < 4; ++j) {
            const int s2 = wave + 8 * j;
            if (s2 < tt) {
                unsigned long long x = pg[j]; unsigned spins = 0;
                while ((unsigned)x == 0u) {
                    __builtin_amdgcn_s_sleep(1);
                    x = __hip_atomic_load(RT + ((size_t)(b * 32 + s2) * DRNN + ch), RLX_AGENT);
                    if (++spins > (1u << 22)) break;
                }
                Pt[(s2 * 64 + lane) * 2] = __uint_as_float((unsigned)x); Pt[(s2 * 64 + lane) * 2 + 1] = __uint_as_float((unsigned)(x >> 32));
            }
        }
        __syncthreads();
        {   float Hin = 0.f;
            for (int s2 = 0; s2 < tt; ++s2) Hin = Pt[(s2 * 64 + lane) * 2] * Hin + Pt[(s2 * 64 + lane) * 2 + 1];
#pragma unroll
            for (int i = 0; i < 8; ++i) {
                const float hv = hloc[i] + acum[i] * Hin;
                ymix[(tokb + i) * D + ch] = (u16)(pk2(hv * gelu_tanh(bflo((unsigned)gr[i])), 0.f) & 0xffff);
            }
        }
    }
}

__device__ __forceinline__ void phase_fix(const Params& p) {
    const u16* side = (const u16*)(p.ws + OFF_SIDE);
    u16* act = (u16*)(p.ws + OFF_PROJ);
    const float* cw = p.ffn_conv_w; const float* cb = p.ffn_conv_b;
    const int tid = opaque_tid();
    for (int t = opaque_bid(); t < (MTOK / 256) * (D / 256); t += gridDim.x) {
        const int pm = t % (MTOK / 256);
        for (int i = tid; i < 2 * DFF; i += NTHREADS) {
            const int j = i % DFF, rr = i / DFF;
            const int cu_ = (j >> 7) * 256 + (j & 127), cv_ = cu_ + 128;
            const bool first = (pm & 7) == 0;
            float u[3], v[3];
            const u16* sp = side + (size_t)pm * 4 * NUP;
            const u16* spp = side + (size_t)(first ? pm : pm - 1) * 4 * NUP;
            if (rr == 0) {
                u[0] = first ? 0.f : bflo(spp[2 * NUP + cu_]); u[1] = first ? 0.f : bflo(spp[3 * NUP + cu_]); u[2] = bflo(sp[cu_]);
                v[0] = first ? 0.f : bflo(spp[2 * NUP + cv_]); v[1] = first ? 0.f : bflo(spp[3 * NUP + cv_]); v[2] = bflo(sp[cv_]);
            } else {
                u[0] = first ? 0.f : bflo(spp[3 * NUP + cu_]); u[1] = bflo(sp[cu_]); u[2] = bflo(sp[NUP + cu_]);
                v[0] = first ? 0.f : bflo(spp[3 * NUP + cv_]); v[1] = bflo(sp[cv_]); v[2] = bflo(sp[NUP + cv_]);
            }
            const float gu = cw[j] * u[0] + cw[NUP + j] * u[1] + cw[2 * NUP + j] * u[2] + cb[j];
            const float gv = cw[DFF + j] * v[0] + cw[NUP + DFF + j] * v[1] + cw[2 * NUP + DFF + j] * v[2] + cb[DFF + j];
            act[(size_t)(pm * 256 + rr) * DFF + j] = (u16)(pk2(siluf_(gu) * gv, 0.f) & 0xffff);
        }
    }
    asm volatile("s_waitcnt vmcnt(0)" ::: "memory");
    __syncthreads();
}

constexpr int N_PHASES = 7;
#ifndef DUP
#define DUP 0
#endif
#ifndef PHM
#define PHM 0xffff
#endif
__global__ void __launch_bounds__(NTHREADS) fwd_megakernel(Params p_in) {
    extern __shared__ __attribute__((aligned(16))) unsigned char dyn_lds[];
    LAS unsigned char* lds = (LAS unsigned char*)dyn_lds;
    volatile LAS unsigned* xbst = (volatile LAS unsigned*)(lds + LDS_MAIN);
    if (threadIdx.x == 0) { xbst[0] = 0u; xbst[1] = 0u; xbst[2] = 0u; xbst[3] = 0u; }
    __syncthreads();
    const XcdBarrier xb = xcd_barrier_post((unsigned*)(p_in.ws + OFF_BAR), xbst);
    const Params& p0 = p_in;
    for (int ph = 0; ph < N_PHASES; ++ph) {
        Params p = p0; p.ws = p0.ws + opaque_zero();
        const float* mod = (const float*)(p.ws + OFF_MOD);
        unsigned long long* xch = (unsigned long long*)(p.ws + OFF_XCH);
        if (ph > 0) xcd_barrier(xb);
        for (int rep = 0; rep < (((DUP >> ph) & 1) ? 2 : 1); ++rep)
        switch (ph) {
        case 0: if (PHM & 1) phase_prep(p, lds); break;
        case 1: if (PHM & 2) phase_norm<0>(p.x, p.norm1_g, mod, MO_SH1, MO_SC1, (u16*)(p.ws + OFF_H), nullptr); break;
        case 2: if (PHM & 4) { EpiProj e{(u16*)(p.ws + OFF_PROJ), (u16*)(p.ws + OFF_KF), (u16*)(p.ws + OFF_VT)}; gemm_phase_stream(lds, (const u16*)(p.ws + OFF_H), (const u16*)(p.ws + OFF_WIN), DIN, D, e);
                  phase_prep2(p, lds, (MTOK / 256) * (DIN / 256) % (int)gridDim.x); } break;
        case 3: if (PHM & 8) { phase_attn(p, lds); if (DUP & 2048) phase_attn(p, lds); phase_rnn(p, lds); if (DUP & 4096) phase_rnn(p, lds); } break;
        case 4: if (PHM & 16) { EpiResidNorm<0> e{p.x, mod + MO_G1, (u16*)(p.ws + OFF_X1B), p.norm2_g, mod, MO_SH2, MO_SC2, (u16*)(p.ws + OFF_H), nullptr, xch, 1u};
                  gemm_phase(lds, (const u16*)(p.ws + OFF_YMIX), (const u16*)(p.ws + OFF_WOUT), D, D, e); } break;
        case 5: if (PHM & 32) { EpiUp e{(u16*)(p.ws + OFF_PROJ), (u16*)(p.ws + OFF_SIDE), p.ffn_conv_w, p.ffn_conv_b}; gemm_phase_up(lds, (const u16*)(p.ws + OFF_H), (const u16*)(p.ws + OFF_WUP), NUP, D, e); } break;
        case 6: if (PHM & 64) { phase_fix(p);
                  EpiResidNorm<1> e{nullptr, mod + MO_G2, (u16*)(p.ws + OFF_X1B), p.final_g, nullptr, 0, 0, nullptr, p.out, xch + 64 * 4 * 256, 2u};
                  gemm_phase(lds, (const u16*)(p.ws + OFF_PROJ), (const u16*)(p.ws + OFF_WDN), D, DFF, e); } break;
        }
    }
}

extern "C" void kernel_launch(void* const* d_in, const int* in_sizes, int n_in, void* d_out, int out_size, void* d_ws, size_t ws_size, hipStream_t stream) {
    static int grid = 0;
    if (grid == 0) {
        int dev = 0, cus = 0, per_cu = 0;
        hipGetDevice(&dev);
        hipDeviceGetAttribute(&cus, hipDeviceAttributeMultiprocessorCount, dev);
        hipFuncSetAttribute((const void*)fwd_megakernel, hipFuncAttributeMaxDynamicSharedMemorySize, LDS_BYTES);
        hipOccupancyMaxActiveBlocksPerMultiprocessor(&per_cu, (const void*)fwd_megakernel, NTHREADS, LDS_BYTES);
        if (per_cu < 1) { fprintf(stderr, "occupancy query says %d blocks/CU\n", per_cu); per_cu = 1; }
        if (per_cu > 1) per_cu = 1;
        grid = cus * per_cu;
        if (grid != 256) fprintf(stderr, "note: grid %d != 256: the fused row-norm exchange expects one 256x256 tile per workgroup in the N=1024 GEMM phases\n", grid);
        if (ws_size < WS_END) fprintf(stderr, "workspace too small: %zu < %zu\n", ws_size, (size_t)WS_END);
    }
    hipMemsetAsync((char*)d_ws + OFF_BAR, 0, ZERO_BYTES, stream);
    Params p{};
    const float** f = (const float**)&p;
    for (int i = 0; i < 21; ++i) f[i] = (const float*)d_in[i];
    p.out = (float*)d_out; p.ws = (unsigned char*)d_ws;
    p.ph_lo = 0; p.ph_hi = N_PHASES;
    void* args[] = {&p};
    hipError_t e = hipLaunchCooperativeKernel((const void*)fwd_megakernel, dim3(grid), dim3(NTHREADS), args, LDS_BYTES, stream);
    if (e != hipSuccess) fprintf(stderr, "cooperative launch failed: %s (grid %d)\n", hipGetErrorString(e), grid);
}
```

```cpp
#include <hip/hip_runtime.h>
#include <hip/hip_bf16.h>
#include <hip/hip_cooperative_groups.h>
#include <cstdio>
namespace cg = cooperative_groups;

#define LAS __attribute__((address_space(3)))
typedef short bf16x8 __attribute__((ext_vector_type(8)));
typedef float f32x4 __attribute__((ext_vector_type(4)));
typedef unsigned short u16;
typedef unsigned u32x4 __attribute__((ext_vector_type(4)));
typedef unsigned u32x2 __attribute__((ext_vector_type(2)));

constexpr int D = 1024, BATCH = 8, SEQ = 2048, MTOK = BATCH * SEQ;
constexpr int DRNN = 512, DATT = 512, DIN = 2560, DFF = 2816, NUP = 5632;
constexpr int NTHREADS = 512;
constexpr int PST = 1536;
constexpr float EPS = 1e-6f;
constexpr int C_XR = 0, C_GR = 512, C_Q = 1024, C_K = 1536, C_V = 2048;
constexpr int MO_SH1 = 0, MO_SC1 = 1024, MO_G1 = 2048, MO_SH2 = 3072, MO_SC2 = 4096, MO_G2 = 5120;

constexpr size_t OFF_BAR = 5u << 20;
constexpr size_t OFF_XCH = OFF_BAR + 16384;
constexpr size_t OFF_MOD = OFF_XCH + (1u << 20);
constexpr size_t OFF_RTOT = OFF_MOD + 196608;
constexpr size_t ZERO_BYTES = 16384 + (1u << 20) + 196608 + (1u << 20);
static_assert(OFF_BAR + ZERO_BYTES <= (8u << 20), "zero region");
constexpr size_t OFF_LSL = 196608;
constexpr size_t OFF_WAT = 200704;
constexpr size_t OFF_WXT = OFF_WAT + 65536;
constexpr size_t OFF_SIDE = 2u << 20;
constexpr size_t OFF_WIN = 8u << 20;
constexpr size_t OFF_WOUT = OFF_WIN + (size_t)DIN * D * 2;
constexpr size_t OFF_WUP = OFF_WOUT + (size_t)D * D * 2;
constexpr size_t OFF_WDN = OFF_WUP + (size_t)NUP * D * 2;
constexpr size_t OFF_H = OFF_WDN + (size_t)D * DFF * 2;
constexpr size_t OFF_PROJ = OFF_H + (size_t)MTOK * D * 2;
constexpr size_t OFF_YMIX = OFF_PROJ + (size_t)MTOK * PST * 2;
constexpr size_t OFF_HL = OFF_YMIX + (size_t)MTOK * D * 2;
constexpr size_t OFF_AC = OFF_HL + (size_t)MTOK * DRNN * 4;
constexpr size_t OFF_X1B = OFF_AC;
constexpr size_t OFF_KF = OFF_AC + (size_t)MTOK * DRNN * 4;
constexpr size_t OFF_VT = OFF_KF + (size_t)MTOK * DATT * 2;
constexpr size_t WS_END = OFF_VT + (size_t)MTOK * DATT * 2;
static_assert(WS_END <= (256u << 20), "workspace");
static_assert((size_t)MTOK * DFF * 2 <= (size_t)MTOK * PST * 2 + (size_t)MTOK * D * 2 + (size_t)MTOK * DRNN * 4, "act fits over proj+ymix+hl");

constexpr int LDS_MAIN = 256 * 528;
constexpr int LDS_BYTES = LDS_MAIN + 16;

struct Params {
    const float *x, *c, *ada_w, *ada_b, *norm1_g, *w_in, *rnn_conv_w, *rnn_conv_b, *rg_wa, *rg_ba, *rg_wx, *rg_bx, *rg_lambda,
        *rel_bias, *w_out, *norm2_g, *w_up, *ffn_conv_w, *ffn_conv_b, *w_down, *final_g;
    float* out;
    unsigned char* ws;
    int ph_lo, ph_hi;
};

__device__ __forceinline__ unsigned opaque_zero() { unsigned z; asm volatile("s_mov_b32 %0, 0" : "=s"(z)); return z; }
__device__ __forceinline__ int opaque_bid() { int t; asm volatile("s_mov_b32 %0, %1" : "=s"(t) : "s"(blockIdx.x)); return t; }
__device__ __forceinline__ int opaque_tid() { int t; asm volatile("v_mov_b32 %0, %1" : "=v"(t) : "v"(threadIdx.x)); return t; }
__device__ __forceinline__ unsigned pk2(float lo, float hi) { unsigned r; asm("v_cvt_pk_bf16_f32 %0, %1, %2" : "=v"(r) : "v"(lo), "v"(hi)); return r; }
__device__ __forceinline__ float bflo(unsigned u) { return __uint_as_float(u << 16); }
__device__ __forceinline__ float bfhi(unsigned u) { return __uint_as_float(u & 0xffff0000u); }
__device__ __forceinline__ float wave_sum(float v) {
#pragma unroll
    for (int o = 1; o < 64; o <<= 1) v += __shfl_xor(v, o);
    return v;
}
__device__ __forceinline__ float sigmoidf_(float v) { return __builtin_amdgcn_rcpf(1.f + __expf(-v)); }
__device__ __forceinline__ float siluf_(float v) { return v * __builtin_amdgcn_rcpf(1.f + __expf(-v)); }
__device__ __forceinline__ float gelu_tanh(float v) {
    const float u = 0.7978845608028654f * (v + 0.044715f * v * v * v);
    const float t = 1.f - 2.f * __builtin_amdgcn_rcpf(__expf(2.f * u) + 1.f);
    return 0.5f * v * (1.f + t);
}


#define XB_TMO      128
#define XB_XCNT(j)  (256  + 64 * (j))
#define XB_XSUB(j)  (1280 + 64 * (j))
#define XB_XGEN(j)  (2304 + 64 * (j))
#define XB_TOP      3328
#define XB_TOPGEN   3392
#define XCD_BAR_WORDS 3456
#define XB_SPIN_CAP (1u << 20)
__device__ __forceinline__ unsigned xb_ld(unsigned* p)              { return __hip_atomic_load(p, __ATOMIC_RELAXED, __HIP_MEMORY_SCOPE_AGENT); }
__device__ __forceinline__ unsigned xb_add(unsigned* p, unsigned v) { return __hip_atomic_fetch_add(p, v, __ATOMIC_RELAXED, __HIP_MEMORY_SCOPE_AGENT); }
__device__ __forceinline__ unsigned xb_xcc_id() { return (unsigned)__builtin_amdgcn_s_getreg((3 << 11) | 20) & 0xFu; }
#define XB_SPIN(cond, bar) do { unsigned _sp = 0; while (cond) { __builtin_amdgcn_s_sleep(1); \
    if ((++_sp & 255u) == 0u) { if (xb_ld(&(bar)[XB_TMO])) break; if (_sp > XB_SPIN_CAP) { atomicAdd(&(bar)[XB_TMO], 1u); break; } } } } while (0)
struct XcdBarrier { unsigned* bar; unsigned x; volatile LAS unsigned* st; };
__device__ __forceinline__ XcdBarrier xcd_barrier_post(unsigned* bar, volatile LAS unsigned* st) {
    XcdBarrier b; b.bar = bar; b.x = xb_xcc_id(); b.st = st;
    if (threadIdx.x == 0) (void)xb_add(&bar[XB_XCNT(b.x)], 1u);
    return b;
}
__device__ __forceinline__ void xcd_barrier_complete(unsigned* bar, unsigned x, unsigned& nloc, unsigned& nx) {
    const unsigned G = gridDim.x * gridDim.y * gridDim.z;
    unsigned sum, cnt, mine, sp = 0u;
    for (;;) {
        sum = 0u; cnt = 0u; mine = 0u;
#pragma unroll
        for (unsigned j = 0; j < 16; ++j) { const unsigned c = xb_ld(&bar[XB_XCNT(j)]); sum += c; cnt += (c > 0u) ? 1u : 0u; mine = (j == x) ? c : mine; }
        if (sum == G) break;
        __builtin_amdgcn_s_sleep(1);
        if ((++sp & 255u) == 0u) { if (xb_ld(&bar[XB_TMO])) break; if (sp > XB_SPIN_CAP) { atomicAdd(&bar[XB_TMO], 1u); break; } }
    }
    nloc = mine > 0u ? mine : 1u; nx = cnt > 0u ? cnt : 1u;
}
__device__ __forceinline__ void xcd_barrier(const XcdBarrier& b) {
    asm volatile("s_waitcnt vmcnt(0)" ::: "memory");
    __syncthreads();
    if (threadIdx.x == 0) {
        unsigned* bar = b.bar;
        __builtin_amdgcn_s_waitcnt(0);
        unsigned nloc = b.st[0], nx = b.st[1];
        if (nloc == 0u) { xcd_barrier_complete(bar, b.x, nloc, nx); b.st[0] = nloc; b.st[1] = nx; }
        const unsigned old = xb_add(&bar[XB_XSUB(b.x)], 1u);
        const unsigned gen = old / nloc;
        if (old + 1u == (gen + 1u) * nloc) {
            __builtin_amdgcn_fence(__ATOMIC_RELEASE, "agent");
            asm volatile("s_waitcnt vmcnt(0)" ::: "memory");
            const unsigned og = xb_add(&bar[XB_TOP], 1u);
            const unsigned tg = og / nx;
            if (og + 1u == (tg + 1u) * nx) xb_add(&bar[XB_TOPGEN], 1u);
            else XB_SPIN(xb_ld(&bar[XB_TOPGEN]) == tg, bar);
            __builtin_amdgcn_fence(__ATOMIC_ACQUIRE, "agent");
            xb_add(&bar[XB_XGEN(b.x)], 1u);
            asm volatile("s_waitcnt vmcnt(0)" ::: "memory");
        } else {
            XB_SPIN(xb_ld(&bar[XB_XGEN(b.x)]) == gen, bar);
            __builtin_amdgcn_fence(__ATOMIC_ACQUIRE, "agent");
            asm volatile("s_waitcnt vmcnt(0)" ::: "memory");
        }
    }
    __syncthreads();
}

constexpr int BM = 256, BK = 64, HALF = 128, HTB = HALF * BK * 2;
__device__ __forceinline__ int lds_byte(int r, int c) {
    int st = (r >> 4) * 2 + (c >> 5), rr = r & 15, cc = c & 31, ob = rr * 64 + cc * 2;
    return st * 1024 + (ob ^ (((ob >> 9) & 1) << 5));
}
__device__ __forceinline__ void stage_rc(int b, int& R, int& C) {
    int st = b / 1024, sb = b % 1024, swz = sb ^ (((sb >> 9) & 1) << 5);
    R = (st >> 1) * 16 + swz / 64; C = (st & 1) * 32 + (swz % 64) / 2;
}
#define G_SA(b, h) (((b) * 2 + (h)) * HTB)
#define G_SB(b, h) ((4 + (b) * 2 + (h)) * HTB)
#define G_STAGE(bufoff, gbase, voff) do { _Pragma("unroll") for (int _i = 0; _i < 2; ++_i) \
        __builtin_amdgcn_global_load_lds((const unsigned*)((const char*)(gbase) + (voff)[_i]), (LAS unsigned*)(lds + (bufoff) + ldsw + _i * 8192), 16, 0, 0); } while (0)
#define G_LDA(dst, b, h) do { _Pragma("unroll") for (int m = 0; m < 4; ++m) _Pragma("unroll") for (int k = 0; k < 2; ++k) dst[m][k] = *(const LAS bf16x8*)(lds + G_SA(b, h) + aoff + m * 2048 + k * 1024); } while (0)
#define G_LDB(dst, b, h) do { _Pragma("unroll") for (int n = 0; n < 2; ++n) _Pragma("unroll") for (int k = 0; k < 2; ++k) dst[n][k] = *(const LAS bf16x8*)(lds + G_SB(b, h) + boff + n * 2048 + k * 1024); } while (0)
#define G_MMA(ai, bj, At, Bt) do { __builtin_amdgcn_s_setprio(1); _Pragma("unroll") for (int m = 0; m < 4; ++m) _Pragma("unroll") for (int n = 0; n < 2; ++n) _Pragma("unroll") for (int k = 0; k < 2; ++k) \
        acc[ai][bj][m][n] = __builtin_amdgcn_mfma_f32_16x16x32_bf16(Bt[n][k], At[m][k], acc[ai][bj][m][n], 0, 0, 0); __builtin_amdgcn_s_setprio(0); } while (0)
#define G_WAIT_V(n) asm volatile("s_waitcnt vmcnt(" #n ")" ::: "memory")
#define G_WAIT_L(n) asm volatile("s_waitcnt lgkmcnt(" #n ")" ::: "memory")
#define G_BAR __builtin_amdgcn_s_barrier()
#define G_SCHED __builtin_amdgcn_sched_barrier(0)

template <class Hook>
__device__ __forceinline__ void gemm_tile(LAS unsigned char* lds, const char* cA, const char* cB, int K, f32x4 (&acc)[2][2][4][2], bool has_hook, const Hook& hook) {
    const int tid = opaque_tid(), wid = __builtin_amdgcn_readfirstlane(tid >> 6), lane = tid & 63, wr = wid >> 2, wc = wid & 3, fr = lane & 15, fq = lane >> 4;
    const int nt = K / BK;
    unsigned voff[2];
#pragma unroll
    for (int i = 0; i < 2; ++i) { int R, C; stage_rc(tid * 16 + i * 8192, R, C); voff[i] = (unsigned)(R * K + C) * 2u; }
    const size_t kstep = (size_t)(BK * 2);
    const size_t hstep = (size_t)HALF * K * 2;
    const unsigned ldsw = (unsigned)wid * 1024u;
    const int aoff = lds_byte(wr * 64 + fr, fq * 8), boff = lds_byte(wc * 32 + fr, fq * 8);
    bf16x8 At[4][2], B0[2][2], B1[2][2];
    G_WAIT_V(0);
    __syncthreads();
    G_STAGE(G_SB(0, 0), cB, voff); G_STAGE(G_SA(0, 0), cA, voff); G_STAGE(G_SB(0, 1), cB + hstep, voff); G_STAGE(G_SA(0, 1), cA + hstep, voff);
    if (has_hook) {
        hook();
        if (wr == 1) G_BAR;
        G_WAIT_V(8); G_BAR;
    } else {
        if (wr == 1) G_BAR;
        G_WAIT_V(4); G_BAR;
    }
#pragma unroll
    for (int a = 0; a < 2; ++a)
#pragma unroll
        for (int b = 0; b < 2; ++b)
#pragma unroll
            for (int m = 0; m < 4; ++m)
#pragma unroll
                for (int n = 0; n < 2; ++n) acc[a][b][m][n] = (f32x4){0.f, 0.f, 0.f, 0.f};
    G_STAGE(G_SB(1, 0), cB + kstep, voff); G_STAGE(G_SA(1, 0), cA + kstep, voff); G_STAGE(G_SB(1, 1), cB + hstep + kstep, voff);
    G_WAIT_V(6); G_BAR;
    for (int t = 0; t < nt - 2; t += 2) {
        const char* a1 = cA + (size_t)(t + 1) * kstep; const char* a2 = cA + (size_t)(t + 2) * kstep; const char* a3 = cA + (size_t)(t + 3) * kstep;
        const char* b2 = cB + (size_t)(t + 2) * kstep; const char* b3 = cB + (size_t)(t + 3) * kstep;
        G_LDB(B0, 0, 0); G_SCHED; G_LDA(At, 0, 0); G_STAGE(G_SA(1, 1), a1 + hstep, voff);
        G_WAIT_L(8); G_BAR; G_WAIT_L(0); G_MMA(0, 0, At, B0); G_BAR; G_SCHED;
        G_LDB(B1, 0, 1); G_STAGE(G_SB(0, 0), b2, voff);
        G_BAR; G_WAIT_L(0); G_MMA(0, 1, At, B1); G_BAR;
        G_LDA(At, 0, 1); G_STAGE(G_SA(0, 0), a2, voff);
        G_BAR; G_WAIT_L(0); G_MMA(1, 0, At, B0); G_BAR; G_SCHED;
        G_STAGE(G_SB(0, 1), b2 + hstep, voff);
        G_WAIT_V(6); G_BAR; G_MMA(1, 1, At, B1); G_BAR;
        G_LDB(B0, 1, 0); G_SCHED; G_LDA(At, 1, 0); G_STAGE(G_SA(0, 1), a2 + hstep, voff);
        G_WAIT_L(8); G_BAR; G_WAIT_L(0); G_MMA(0, 0, At, B0); G_BAR; G_SCHED;
        G_LDB(B1, 1, 1); G_STAGE(G_SB(1, 0), b3, voff);
        G_BAR; G_WAIT_L(0); G_MMA(0, 1, At, B1); G_BAR;
        G_LDA(At, 1, 1); G_STAGE(G_SA(1, 0), a3, voff);
        G_BAR; G_WAIT_L(0); G_MMA(1, 0, At, B0); G_BAR; G_SCHED;
        G_STAGE(G_SB(1, 1), b3 + hstep, voff);
        G_WAIT_V(6); G_BAR; G_MMA(1, 1, At, B1); G_BAR;
    }
    {   const char* aL = cA + (size_t)(nt - 1) * kstep;
        G_LDB(B0, 0, 0); G_LDA(At, 0, 0); G_STAGE(G_SA(1, 1), aL + hstep, voff);
        G_BAR; G_WAIT_L(0); G_MMA(0, 0, At, B0); G_BAR;
        G_LDB(B1, 0, 1); G_BAR; G_WAIT_L(0); G_MMA(0, 1, At, B1); G_BAR;
        G_LDA(At, 0, 1); G_WAIT_V(4); G_BAR; G_WAIT_L(0); G_MMA(1, 0, At, B0); G_MMA(1, 1, At, B1); G_BAR; }
    {   G_LDB(B0, 1, 0); G_LDA(At, 1, 0); G_WAIT_V(2); G_BAR; G_WAIT_L(0); G_MMA(0, 0, At, B0); G_BAR;
        G_LDB(B1, 1, 1); G_WAIT_V(0); G_BAR; G_WAIT_L(0); G_MMA(0, 1, At, B1); G_BAR;
        G_LDA(At, 1, 1); G_BAR; G_WAIT_L(0); G_MMA(1, 0, At, B0); G_MMA(1, 1, At, B1); G_BAR; }
    if (wr == 0) G_BAR;
}

__device__ __forceinline__ void st16_pair(u16* p32  , unsigned p0x, unsigned p0y, unsigned p1x, unsigned p1y, int fq) {
    const auto r0 = __builtin_amdgcn_permlane16_swap(p0x, p1x, false, false);
    const auto r1 = __builtin_amdgcn_permlane16_swap(p0y, p1y, false, false);
    *(u32x4*)(p32 + (fq & 1) * 16 + (fq >> 1) * 8) = (u32x4){(unsigned)r0[0], (unsigned)r1[0], (unsigned)r0[1], (unsigned)r1[1]};
}
struct EpiProj {
    u16* O; u16* Kf; u16* Vf;
    __device__ __forceinline__ void operator()(LAS unsigned char* lds, const f32x4 (&acc)[2][2][4][2], int pm, int pn) const {
        const int tid = opaque_tid(), wid = tid >> 6, lane = tid & 63, wr = wid >> 2, wc = wid & 3, fr = lane & 15, fq = lane >> 4;
        if (pn < 6) {
#pragma unroll
            for (int ai = 0; ai < 2; ++ai)
#pragma unroll
                for (int m = 0; m < 4; ++m) {
                    const int row = pm * 256 + ai * 128 + wr * 64 + m * 16 + fr;
#pragma unroll
                    for (int bj = 0; bj < 2; ++bj) {
                        const f32x4 a0 = acc[ai][bj][m][0], a1 = acc[ai][bj][m][1];
                        st16_pair(O + (size_t)row * PST + pn * 256 + bj * 128 + wc * 32, pk2(a0.x, a0.y), pk2(a0.z, a0.w), pk2(a1.x, a1.y), pk2(a1.z, a1.w), fq);
                    }
                }
        } else if (pn < 8) {
            const int b = (pm * 256) / SEQ, s0 = (pm * 256) & (SEQ - 1);
#pragma unroll
            for (int bj = 0; bj < 2; ++bj)
#pragma unroll
                for (int n = 0; n < 2; ++n) {
                    const int colk = (pn - 6) * 256 + bj * 128 + wc * 32 + n * 16 + fq * 4;
                    const int hh = colk >> 6, d = colk & 63;
                    u16* kb_ = Kf + ((size_t)(b * 8 + hh) * 64 * 4 + (d >> 4)) * 512 + ((d >> 3) & 1) * 256 + (d & 7);
#pragma unroll
                    for (int ai = 0; ai < 2; ++ai)
#pragma unroll
                        for (int m = 0; m < 4; ++m) {
                            const int sk = s0 + ai * 128 + wr * 64 + m * 16 + fr;
                            const f32x4 a = acc[ai][bj][m][n];
                            u32x2 o; o.x = pk2(a.x, a.y); o.y = pk2(a.z, a.w);
                            *(u32x2*)(kb_ + (size_t)(sk >> 5) * 2048 + (sk & 31) * 8) = o;
                        }
                }
        } else {
            const int b = (pm * 256) / SEQ, s0 = (pm * 256) & (SEQ - 1);
            const int gk = (fr >> 2) & 1, jj = (fr >> 3) * 4 + (fr & 3);
#pragma unroll
            for (int bj = 0; bj < 2; ++bj)
#pragma unroll
                for (int n = 0; n < 2; ++n) {
                    const int colv = (pn - 8) * 256 + bj * 128 + wc * 32 + n * 16 + fq * 4;
                    const int hh = colv >> 6, d = colv & 63;
                    u16* vb_ = Vf + (((size_t)(b * 8 + hh) * 128 * 2 + (d >> 5)) * 64 + gk * 32 + (d & 31)) * 8 + jj;
#pragma unroll
                    for (int ai = 0; ai < 2; ++ai)
#pragma unroll
                        for (int m = 0; m < 4; ++m) {
                            const int kg = (s0 + ai * 128 + wr * 64 + m * 16) >> 4;
                            const f32x4 a = acc[ai][bj][m][n];
                            const unsigned lo = pk2(a.x, a.y), hi = pk2(a.z, a.w);
                            u16* v = vb_ + (size_t)kg * 1024;
                            v[0] = (u16)(lo & 0xffff); v[8] = (u16)(lo >> 16); v[16] = (u16)(hi & 0xffff); v[24] = (u16)(hi >> 16);
                        }
                }
        }
    }
};
struct EpiResid {
    const float* src; float* out; const float* gate;
    __device__ __forceinline__ void operator()(LAS unsigned char* lds, const f32x4 (&acc)[2][2][4][2], int pm, int pn) const {
        const int tid = opaque_tid(), wid = tid >> 6, lane = tid & 63, wr = wid >> 2, wc = wid & 3, fr = lane & 15, fq = lane >> 4;
        const int b = (pm * 256) / SEQ;
#pragma unroll
        for (int bj = 0; bj < 2; ++bj)
#pragma unroll
            for (int n = 0; n < 2; ++n) {
                const int col = pn * 256 + bj * 128 + wc * 32 + n * 16 + fq * 4;
                const float4 g = *(const float4*)(gate + b * 6144 + col);
#pragma unroll
                for (int ai = 0; ai < 2; ++ai)
#pragma unroll
                    for (int m = 0; m < 4; ++m) {
                        const int row = pm * 256 + ai * 128 + wr * 64 + m * 16 + fr;
                        const f32x4 a = acc[ai][bj][m][n];
                        const float4 s = *(const float4*)(src + (size_t)row * D + col);
                        float4 o; o.x = s.x + g.x * a.x; o.y = s.y + g.y * a.y; o.z = s.z + g.z * a.z; o.w = s.w + g.w * a.w;
                        *(float4*)(out + (size_t)row * D + col) = o;
                    }
            }
    }
};

typedef __attribute__((address_space(1))) unsigned long long gu64;
#define RLX_AGENT __ATOMIC_RELAXED, __HIP_MEMORY_SCOPE_AGENT
template <int MODE>
struct EpiResidNorm {
    const float* src; const float* gate; u16* x1b; const float* gain; const float* mod; int mo_sh, mo_sc; u16* hout; float* fout; unsigned long long* xch; unsigned tag;
    __device__ __forceinline__ void operator()(LAS unsigned char* lds, f32x4 (&acc)[2][2][4][2], int pm, int pn) const {
        const int tid = opaque_tid(), wid = tid >> 6, lane = tid & 63, wr = wid >> 2, wc = wid & 3, fr = lane & 15, fq = lane >> 4;
        const int b = (pm * 256) / SEQ;
        float ss[2][4];
#pragma unroll
        for (int ai = 0; ai < 2; ++ai)
#pragma unroll
            for (int m = 0; m < 4; ++m) ss[ai][m] = 0.f;
        if (MODE == 0) {
        float4 sv4[4]; float4 g = *(const float4*)(gate + b * 6144 + pn * 256 + wc * 32 + fq * 4), gn = g;
#define ERN_LOAD4(u) do { _Pragma("unroll") for (int m = 0; m < 4; ++m) { \
            const int col_ = pn * 256 + ((u) >> 2) * 128 + wc * 32 + (((u) >> 1) & 1) * 16 + fq * 4, row_ = pm * 256 + ((u) & 1) * 128 + wr * 64 + m * 16 + fr; \
            sv4[m] = *(const float4*)(src + (size_t)row_ * D + col_); } } while (0)
        ERN_LOAD4(0);
#pragma unroll
        for (int u = 0; u < 8; ++u) {
            const int bj = u >> 2, n = (u >> 1) & 1, ai = u & 1;
            const int col = pn * 256 + bj * 128 + wc * 32 + n * 16 + fq * 4;
            g = gn;
#pragma unroll
            for (int m = 0; m < 4; ++m) {
                f32x4 a = acc[ai][bj][m][n];
                const float4 sx = sv4[m];
                a.x = sx.x + g.x * a.x; a.y = sx.y + g.y * a.y; a.z = sx.z + g.z * a.z; a.w = sx.w + g.w * a.w;
                acc[ai][bj][m][n] = a;
                ss[ai][m] += (a.x * a.x + a.y * a.y) + (a.z * a.z + a.w * a.w);
            }
            __builtin_amdgcn_sched_barrier(0);
            if (u < 7) { ERN_LOAD4(u + 1); if (((u + 1) & 1) == 0) gn = *(const float4*)(gate + b * 6144 + pn * 256 + ((u + 1) >> 2) * 128 + wc * 32 + (((u + 1) >> 1) & 1) * 16 + fq * 4); }
            __builtin_amdgcn_sched_barrier(0);
            if (n == 1) {
#pragma unroll
                for (int m = 0; m < 4; ++m) {
                    const int row = pm * 256 + ai * 128 + wr * 64 + m * 16 + fr;
                    const f32x4 a0 = acc[ai][bj][m][0], a1 = acc[ai][bj][m][1];
                    st16_pair(x1b + (size_t)row * D + pn * 256 + bj * 128 + wc * 32, pk2(a0.x, a0.y), pk2(a0.z, a0.w), pk2(a1.x, a1.y), pk2(a1.z, a1.w), fq);
                }
            }
            __builtin_amdgcn_sched_barrier(0);
        }
#undef ERN_LOAD4
        } else {
        u32x4 raw[2][2][4];
#define ERN_LD16(bj_) do { _Pragma("unroll") for (int ai = 0; ai < 2; ++ai) _Pragma("unroll") for (int m = 0; m < 4; ++m) \
            raw[bj_][ai][m] = *(const u32x4*)(x1b + (size_t)(pm * 256 + ai * 128 + wr * 64 + m * 16 + fr) * D + pn * 256 + (bj_) * 128 + wc * 32 + (fq & 1) * 16 + (fq >> 1) * 8); } while (0)
#define ERN_CMP16(bj_, ai_) do { _Pragma("unroll") for (int m = 0; m < 4; ++m) { \
            const u32x4 rv = raw[bj_][ai_][m]; \
            const auto r0 = __builtin_amdgcn_permlane16_swap(rv.x, rv.z, false, false); \
            const auto r1 = __builtin_amdgcn_permlane16_swap(rv.y, rv.w, false, false); \
            const unsigned pq[2][2] = {{(unsigned)r0[0], (unsigned)r1[0]}, {(unsigned)r0[1], (unsigned)r1[1]}}; \
            _Pragma("unroll") for (int n = 0; n < 2; ++n) { \
                f32x4 a = acc[ai_][bj_][m][n]; \
                a.x = bflo(pq[n][0]) + gq[bj_][n].x * a.x; a.y = bfhi(pq[n][0]) + gq[bj_][n].y * a.y; a.z = bflo(pq[n][1]) + gq[bj_][n].z * a.z; a.w = bfhi(pq[n][1]) + gq[bj_][n].w * a.w; \
                acc[ai_][bj_][m][n] = a; \
                ss[ai_][m] += (a.x * a.x + a.y * a.y) + (a.z * a.z + a.w * a.w); } } } while (0)
        float4 gq[2][2];
#pragma unroll
        for (int bj = 0; bj < 2; ++bj)
#pragma unroll
            for (int n = 0; n < 2; ++n) gq[bj][n] = *(const float4*)(gate + b * 6144 + pn * 256 + bj * 128 + wc * 32 + n * 16 + fq * 4);
        ERN_LD16(0);
        __builtin_amdgcn_sched_barrier(0);
        ERN_CMP16(0, 0);
        __builtin_amdgcn_sched_barrier(0);
        ERN_LD16(1);
        __builtin_amdgcn_sched_barrier(0);
        ERN_CMP16(0, 1);
        __builtin_amdgcn_sched_barrier(0);
        ERN_CMP16(1, 0); ERN_CMP16(1, 1);
#undef ERN_LD16
#undef ERN_CMP16
        }
        float4 g2[4];
        if (MODE == 1) {
#pragma unroll
            for (int q = 0; q < 4; ++q) g2[q] = *(const float4*)(gain + pn * 256 + (q >> 1) * 128 + wc * 32 + (q & 1) * 16 + fq * 4);
        }
        LAS float* red = (LAS float*)lds;
        LAS float* rin = red + 1024;
#pragma unroll
        for (int ai = 0; ai < 2; ++ai)
#pragma unroll
            for (int m = 0; m < 4; ++m) {
                float v = ss[ai][m]; v += __shfl_xor(v, 16); v += __shfl_xor(v, 32);
                if (fq == 0) red[wc * 256 + ai * 128 + wr * 64 + m * 16 + fr] = v;
            }
        __syncthreads();
        if (tid < 256) {
            const float mine = (red[tid] + red[256 + tid]) + (red[512 + tid] + red[768 + tid]);
            gu64* g = (gu64*)(xch + ((size_t)pm * 4) * 256 + tid);
            __hip_atomic_store(g + pn * 256, ((unsigned long long)tag << 32) | (unsigned long long)__float_as_uint(mine), RLX_AGENT);
            float part[4];
#pragma unroll
            for (int q = 0; q < 4; ++q) {
                part[q] = mine;
                if (q != pn) {
                    unsigned spins = 0;
                    for (;;) {
                        const unsigned long long x = __hip_atomic_load(g + q * 256, RLX_AGENT);
                        if ((unsigned)(x >> 32) == tag) { part[q] = __uint_as_float((unsigned)x); break; }
                        __builtin_amdgcn_s_sleep(1);
                        if (++spins > (1u << 22)) break;
                    }
                }
            }
            const float tot = (part[0] + part[1]) + (part[2] + part[3]);
            rin[tid] = rsqrtf(tot * (1.f / D) + EPS);
        }
        __syncthreads();
        if (MODE == 0) {
#pragma unroll
            for (int bj = 0; bj < 2; ++bj) {
                float4 gq[2], shq[2];
#pragma unroll
                for (int n = 0; n < 2; ++n) {
                    const int col = pn * 256 + bj * 128 + wc * 32 + n * 16 + fq * 4;
                    gq[n] = *(const float4*)(gain + col);
                    const float4 sc = *(const float4*)(mod + b * 6144 + mo_sc + col); shq[n] = *(const float4*)(mod + b * 6144 + mo_sh + col);
                    gq[n].x *= 1.f + sc.x; gq[n].y *= 1.f + sc.y; gq[n].z *= 1.f + sc.z; gq[n].w *= 1.f + sc.w;
                }
#pragma unroll
                for (int ai = 0; ai < 2; ++ai)
#pragma unroll
                    for (int m = 0; m < 4; ++m) {
                        const int lrow = ai * 128 + wr * 64 + m * 16 + fr, row = pm * 256 + lrow;
                        const float r = rin[lrow];
                        const f32x4 a0 = acc[ai][bj][m][0], a1 = acc[ai][bj][m][1];
                        st16_pair(hout + (size_t)row * D + pn * 256 + bj * 128 + wc * 32,
                                  pk2(a0.x * r * gq[0].x + shq[0].x, a0.y * r * gq[0].y + shq[0].y), pk2(a0.z * r * gq[0].z + shq[0].z, a0.w * r * gq[0].w + shq[0].w),
                                  pk2(a1.x * r * gq[1].x + shq[1].x, a1.y * r * gq[1].y + shq[1].y), pk2(a1.z * r * gq[1].z + shq[1].z, a1.w * r * gq[1].w + shq[1].w), fq);
                    }
            }
        } else {
#pragma unroll
        for (int bj = 0; bj < 2; ++bj)
#pragma unroll
            for (int n = 0; n < 2; ++n) {
                const int col = pn * 256 + bj * 128 + wc * 32 + n * 16 + fq * 4;
                float4 g, sh = make_float4(0.f, 0.f, 0.f, 0.f);
                if (MODE == 1) g = g2[bj * 2 + n];
                else {
                    g = *(const float4*)(gain + col);
                    const float4 sc = *(const float4*)(mod + b * 6144 + mo_sc + col); sh = *(const float4*)(mod + b * 6144 + mo_sh + col);
                    g.x *= 1.f + sc.x; g.y *= 1.f + sc.y; g.z *= 1.f + sc.z; g.w *= 1.f + sc.w;
                }
#pragma unroll
                for (int ai = 0; ai < 2; ++ai)
#pragma unroll
                    for (int m = 0; m < 4; ++m) {
                        const int lrow = ai * 128 + wr * 64 + m * 16 + fr, row = pm * 256 + lrow;
                        const float r = rin[lrow];
                        const f32x4 a = acc[ai][bj][m][n];
                        if (MODE == 0) {
                            u32x2 o; o.x = pk2(a.x * r * g.x + sh.x, a.y * r * g.y + sh.y); o.y = pk2(a.z * r * g.z + sh.z, a.w * r * g.w + sh.w);
                            *(u32x2*)(hout + (size_t)row * D + col) = o;
                        } else {
                            f32x4 o; o.x = a.x * r * g.x; o.y = a.y * r * g.y; o.z = a.z * r * g.z; o.w = a.w * r * g.w;
                            *(f32x4*)(fout + (size_t)row * D + col) = o;
                        }
                    }
            }
        }
    }
};
struct EpiUp {
    u16* act; u16* side; const float* cw; const float* cb;
    __device__ __forceinline__ void operator()(LAS unsigned char* lds, const f32x4 (&acc)[2][2][4][2], int pm, int pn, u32x4 (&outv)[4], u32x4 (&sidev)[2][2]) const {
        const int tid = opaque_tid(), wid = tid >> 6, lane = tid & 63, wr = wid >> 2, wc = wid & 3, fr = lane & 15, fq = lane >> 4;
        const int cgp = tid & 15, rg = tid >> 4;
        const int ju = pn * 128 + cgp * 8;
        float wu[3][8], wv[3][8], bu[8], bv[8];
#pragma unroll
        for (int k = 0; k < 3; ++k) {
            const float4 a0 = *(const float4*)(cw + k * NUP + ju), a1 = *(const float4*)(cw + k * NUP + ju + 4);
            const float4 c0 = *(const float4*)(cw + k * NUP + DFF + ju), c1 = *(const float4*)(cw + k * NUP + DFF + ju + 4);
            wu[k][0] = a0.x; wu[k][1] = a0.y; wu[k][2] = a0.z; wu[k][3] = a0.w; wu[k][4] = a1.x; wu[k][5] = a1.y; wu[k][6] = a1.z; wu[k][7] = a1.w;
            wv[k][0] = c0.x; wv[k][1] = c0.y; wv[k][2] = c0.z; wv[k][3] = c0.w; wv[k][4] = c1.x; wv[k][5] = c1.y; wv[k][6] = c1.z; wv[k][7] = c1.w;
        }
        {   const float4 a0 = *(const float4*)(cb + ju), a1 = *(const float4*)(cb + ju + 4), c0 = *(const float4*)(cb + DFF + ju), c1 = *(const float4*)(cb + DFF + ju + 4);
            bu[0] = a0.x; bu[1] = a0.y; bu[2] = a0.z; bu[3] = a0.w; bu[4] = a1.x; bu[5] = a1.y; bu[6] = a1.z; bu[7] = a1.w;
            bv[0] = c0.x; bv[1] = c0.y; bv[2] = c0.z; bv[3] = c0.w; bv[4] = c1.x; bv[5] = c1.y; bv[6] = c1.z; bv[7] = c1.w; }
#pragma unroll
        for (int ai = 0; ai < 2; ++ai)
#pragma unroll
            for (int m = 0; m < 4; ++m) {
                const int row = ai * 128 + wr * 64 + m * 16 + fr;
#pragma unroll
                for (int bj = 0; bj < 2; ++bj)
#pragma unroll
                    for (int n = 0; n < 2; ++n) {
                        const int col = bj * 128 + wc * 32 + n * 16 + fq * 4;
                        const f32x4 a = acc[ai][bj][m][n];
                        u32x2 o; o.x = pk2(a.x, a.y); o.y = pk2(a.z, a.w);
                        *(LAS u32x2*)(lds + row * 528 + col * 2) = o;
                    }
            }
        __syncthreads();
        float fu2[8], fu1[8], fv2[8], fv1[8];
#pragma unroll
        for (int q = 0; q < 8; ++q) { fu2[q] = 0.f; fu1[q] = 0.f; fv2[q] = 0.f; fv1[q] = 0.f; }
        if (rg > 0) {
            const u32x4 a2 = *(const LAS u32x4*)(lds + (rg * 8 - 2) * 528 + cgp * 16), b2 = *(const LAS u32x4*)(lds + (rg * 8 - 2) * 528 + 256 + cgp * 16);
            const u32x4 a1 = *(const LAS u32x4*)(lds + (rg * 8 - 1) * 528 + cgp * 16), b1 = *(const LAS u32x4*)(lds + (rg * 8 - 1) * 528 + 256 + cgp * 16);
#pragma unroll
            for (int q = 0; q < 4; ++q) {
                fu2[2 * q] = bflo(a2[q]); fu2[2 * q + 1] = bfhi(a2[q]); fv2[2 * q] = bflo(b2[q]); fv2[2 * q + 1] = bfhi(b2[q]);
                fu1[2 * q] = bflo(a1[q]); fu1[2 * q + 1] = bfhi(a1[q]); fv1[2 * q] = bflo(b1[q]); fv1[2 * q + 1] = bfhi(b1[q]);
            }
        }
#pragma unroll
        for (int rr = 0; rr < 8; ++rr) {
            const int row = rg * 8 + rr;
            const u32x4 cu = *(const LAS u32x4*)(lds + row * 528 + cgp * 16), cv = *(const LAS u32x4*)(lds + row * 528 + 256 + cgp * 16);
            float fu0[8], fv0[8];
#pragma unroll
            for (int q = 0; q < 4; ++q) { fu0[2 * q] = bflo(cu[q]); fu0[2 * q + 1] = bfhi(cu[q]); fv0[2 * q] = bflo(cv[q]); fv0[2 * q + 1] = bfhi(cv[q]); }
            {
                unsigned o[4];
#pragma unroll
                for (int q = 0; q < 4; ++q) {
                    const float gu_lo = wu[0][2 * q] * fu2[2 * q] + wu[1][2 * q] * fu1[2 * q] + wu[2][2 * q] * fu0[2 * q] + bu[2 * q];
                    const float gu_hi = wu[0][2 * q + 1] * fu2[2 * q + 1] + wu[1][2 * q + 1] * fu1[2 * q + 1] + wu[2][2 * q + 1] * fu0[2 * q + 1] + bu[2 * q + 1];
                    const float gv_lo = wv[0][2 * q] * fv2[2 * q] + wv[1][2 * q] * fv1[2 * q] + wv[2][2 * q] * fv0[2 * q] + bv[2 * q];
                    const float gv_hi = wv[0][2 * q + 1] * fv2[2 * q + 1] + wv[1][2 * q + 1] * fv1[2 * q + 1] + wv[2][2 * q + 1] * fv0[2 * q + 1] + bv[2 * q + 1];
                    o[q] = pk2(siluf_(gu_lo) * gv_lo, siluf_(gu_hi) * gv_hi);
                }
                if (rr < 4) { if (row >= 2) *(u32x4*)(act + (size_t)(pm * 256 + row) * DFF + ju) = (u32x4){o[0], o[1], o[2], o[3]}; }
                else outv[rr - 4] = (u32x4){o[0], o[1], o[2], o[3]};
            }
            if (rr < 2 && rg == 0) { u16* sp = side + ((size_t)pm * 4 + rr) * NUP + pn * 256 + cgp * 8; *(u32x4*)sp = cu; *(u32x4*)(sp + 128) = cv; }
            if (rr >= 6) { sidev[rr & 1][0] = cu; sidev[rr & 1][1] = cv; }
#pragma unroll
            for (int q = 0; q < 8; ++q) { fu2[q] = fu1[q]; fu1[q] = fu0[q]; fv2[q] = fv1[q]; fv1[q] = fv0[q]; }
        }
        __syncthreads();
    }
    __device__ __forceinline__ void flush(int pm, int pn, const u32x4 (&outv)[4], const u32x4 (&sidev)[2][2]) const {
        const int tid = opaque_tid(), cgp = tid & 15, rg = tid >> 4, ju = pn * 128 + cgp * 8;
#pragma unroll
        for (int rr = 4; rr < 8; ++rr) { const int row = rg * 8 + rr; *(u32x4*)(act + (size_t)(pm * 256 + row) * DFF + ju) = outv[rr - 4]; }
        if (rg == 31) {
#pragma unroll
            for (int k = 0; k < 2; ++k) { u16* sp = side + ((size_t)pm * 4 + 2 + k) * NUP + pn * 256 + cgp * 8; *(u32x4*)sp = sidev[k][0]; *(u32x4*)(sp + 128) = sidev[k][1]; }
        }
    }
};

template <class Epi>
__device__ __forceinline__ void gemm_phase_stream(LAS unsigned char* lds, const u16* A, const u16* Bt, int N, int K, const Epi& E) {
    const int nM = MTOK / 256, nN = N / 256, ntiles = nM * nN;
    int t0 = blockIdx.x;
    if (t0 >= ntiles) return;
    const int tid = opaque_tid(), wid = __builtin_amdgcn_readfirstlane(tid >> 6), lane = tid & 63, wr = wid >> 2, wc = wid & 3, fr = lane & 15, fq = lane >> 4;
    const int nt = K / BK;
    unsigned voff[2];
#pragma unroll
    for (int i = 0; i < 2; ++i) { int R, C; stage_rc(tid * 16 + i * 8192, R, C); voff[i] = (unsigned)(R * K + C) * 2u; }
    const size_t kstep = (size_t)(BK * 2);
    const size_t hstep = (size_t)HALF * K * 2;
    const size_t tstep = 2 * hstep;
    const unsigned ldsw = (unsigned)wid * 1024u;
    const int aoff = lds_byte(wr * 64 + fr, fq * 8), boff = lds_byte(wc * 32 + fr, fq * 8);
    f32x4 acc[2][2][4][2];
    bf16x8 At[4][2], B0[2][2], B1[2][2];
    const char* cA = (const char*)A + (size_t)(t0 % nM) * tstep; const char* cB = (const char*)Bt + (size_t)(t0 / nM) * tstep;
    G_WAIT_V(0);
    __syncthreads();
    G_STAGE(G_SB(0, 0), cB, voff); G_STAGE(G_SB(0, 1), cB + hstep, voff); G_STAGE(G_SA(0, 0), cA, voff); G_STAGE(G_SA(0, 1), cA + hstep, voff);
    if (wr == 1) G_BAR;
    G_WAIT_V(2); G_BAR;
    G_STAGE(G_SB(1, 0), cB + kstep, voff); G_STAGE(G_SA(1, 0), cA + kstep, voff); G_STAGE(G_SB(1, 1), cB + hstep + kstep, voff);
    G_WAIT_V(6); G_BAR;
    for (int tcur = t0; tcur < ntiles; tcur += gridDim.x) {
        const int tnext = tcur + (int)gridDim.x;
        const bool has_next = tnext < ntiles;
        const char* nA = has_next ? (const char*)A + (size_t)(tnext % nM) * tstep : cA; const char* nB = has_next ? (const char*)Bt + (size_t)(tnext / nM) * tstep : cB;
#pragma unroll
        for (int a = 0; a < 2; ++a)
#pragma unroll
            for (int b = 0; b < 2; ++b)
#pragma unroll
                for (int m = 0; m < 4; ++m)
#pragma unroll
                    for (int n = 0; n < 2; ++n) acc[a][b][m][n] = (f32x4){0.f, 0.f, 0.f, 0.f};
        for (int t = 0; t < nt; t += 2) {
            const bool last = (t == nt - 2);
            const char* a1 = cA + (size_t)(t + 1) * kstep;
            const char* a2 = last ? nA : cA + (size_t)(t + 2) * kstep; const char* b2 = last ? nB : cB + (size_t)(t + 2) * kstep;
            const char* a3 = a2 + kstep; const char* b3 = b2 + kstep;
            G_LDB(B0, 0, 0); G_LDB(B1, 0, 1); G_SCHED; G_LDA(At, 0, 0); G_STAGE(G_SA(1, 1), a1 + hstep, voff);
            G_WAIT_V(8); G_WAIT_L(0); G_BAR; G_MMA(0, 0, At, B0); G_MMA(0, 1, At, B1); G_BAR; G_SCHED;
            G_LDA(At, 0, 1); G_STAGE(G_SB(0, 0), b2, voff); G_STAGE(G_SB(0, 1), b2 + hstep, voff); G_STAGE(G_SA(0, 0), a2, voff);
            G_WAIT_V(8); G_WAIT_L(0); G_BAR; G_MMA(1, 0, At, B0); G_MMA(1, 1, At, B1); G_BAR; G_SCHED;
            G_LDB(B0, 1, 0); G_LDB(B1, 1, 1); G_SCHED; G_LDA(At, 1, 0); G_STAGE(G_SA(0, 1), a2 + hstep, voff);
            G_WAIT_V(8); G_WAIT_L(0); G_BAR; G_MMA(0, 0, At, B0); G_MMA(0, 1, At, B1); G_BAR; G_SCHED;
            G_LDA(At, 1, 1); G_STAGE(G_SB(1, 0), b3, voff); G_STAGE(G_SB(1, 1), b3 + hstep, voff); G_STAGE(G_SA(1, 0), a3, voff);
            G_WAIT_V(8); G_WAIT_L(0); G_BAR; G_MMA(1, 0, At, B0); G_MMA(1, 1, At, B1); G_BAR; G_SCHED;
        }
        E(lds, acc, tcur % nM, tcur / nM);
        cA = nA; cB = nB;
    }
    G_WAIT_V(0);
    if (wr == 0) G_BAR;
    G_BAR;
}

__device__ __forceinline__ void gemm_phase_up(LAS unsigned char* lds, const u16* A, const u16* Bt, int N, int K, const EpiUp& E) {
    const int nM = MTOK / 256, nN = N / 256, ntiles = nM * nN;
    u32x4 outv[4], sidev[2][2];
#pragma unroll
    for (int i = 0; i < 4; ++i) outv[i] = (u32x4){0u, 0u, 0u, 0u};
#pragma unroll
    for (int i = 0; i < 2; ++i) { sidev[i][0] = (u32x4){0u, 0u, 0u, 0u}; sidev[i][1] = (u32x4){0u, 0u, 0u, 0u}; }
    int ppm = 0, ppn = 0; bool has = false;
    for (int t = blockIdx.x; t < ntiles; t += gridDim.x) {
        const int pm = t % nM, pn = t / nM;
        f32x4 acc[2][2][4][2];
        gemm_tile(lds, (const char*)(A + (size_t)pm * 256 * K), (const char*)(Bt + (size_t)pn * 256 * K), K, acc, has, [&] { E.flush(ppm, ppn, outv, sidev); });
        E(lds, acc, pm, pn, outv, sidev);
        ppm = pm; ppn = pn; has = true;
    }
    if (has) E.flush(ppm, ppn, outv, sidev);
}
template <class Epi>
__device__ __forceinline__ void gemm_phase(LAS unsigned char* lds, const u16* A, const u16* Bt, int N, int K, const Epi& E) {
    const int nM = MTOK / 256, nN = N / 256, ntiles = nM * nN;
    for (int t = blockIdx.x; t < ntiles; t += gridDim.x) {
        const int pm = t % nM, pn = t / nM;
        f32x4 acc[2][2][4][2];
        gemm_tile(lds, (const char*)(A + (size_t)pm * 256 * K), (const char*)(Bt + (size_t)pn * 256 * K), K, acc, false, [] {});
        E(lds, acc, pm, pn);
    }
}

__device__ __forceinline__ void transpose_tile(LAS float* T, const float* W, int K, int N, u16* WT, int kt, int ntl, bool perm_up) {
    const int tid = opaque_tid(), k0 = kt * 64, n0 = ntl * 128;
    const int r = tid >> 5, c4 = tid & 31;
#pragma unroll
    for (int pass = 0; pass < 4; ++pass) {
        const int kk = pass * 16 + r;
        const float4 v = *(const float4*)(W + (size_t)(k0 + kk) * N + n0 + c4 * 4);
        LAS float* t = T + kk * 129 + c4 * 4;
        t[0] = v.x; t[1] = v.y; t[2] = v.z; t[3] = v.w;
    }
    __syncthreads();
    const int n = tid >> 2, kq = tid & 3;
    unsigned o[8];
#pragma unroll
    for (int i = 0; i < 8; ++i) o[i] = pk2(T[(kq * 16 + 2 * i) * 129 + n], T[(kq * 16 + 2 * i + 1) * 129 + n]);
    int nrow = n0 + n;
    if (perm_up) { const int j = nrow < DFF ? nrow : nrow - DFF; nrow = (j >> 7) * 256 + (nrow < DFF ? 0 : 128) + (j & 127); }
    uint4* dst = (uint4*)(WT + (size_t)nrow * K + k0 + kq * 16);
    dst[0] = make_uint4(o[0], o[1], o[2], o[3]); dst[1] = make_uint4(o[4], o[5], o[6], o[7]);
    __syncthreads();
}

__device__ __forceinline__ void phase_prep(const Params& p, LAS unsigned char* lds) {
    const int tid = opaque_tid(), wave = tid >> 6, lane = tid & 63;
    constexpr int T_ADA = 192, T_MISC = 1;
    constexpr int T_WIN = (D / 64) * (DIN / 128);
    constexpr int NT = T_ADA + T_MISC + T_WIN;
    float* mod = (float*)(p.ws + OFF_MOD);
    for (int it = blockIdx.x; it < NT; it += gridDim.x) {
        int r = it;
        if (r < T_ADA) {
            const int cgp = r >> 1, kh = r & 1;
            LAS float* sc = (LAS float*)lds;
            LAS float* red = sc + 4096;
            for (int i = tid; i < 4096; i += NTHREADS) { const int b = i >> 9, k = i & 511; sc[i] = siluf_(p.c[b * 1024 + kh * 512 + k]); }
            __syncthreads();
            const int col = cgp * 64 + lane;
            float a[8] = {0.f, 0.f, 0.f, 0.f, 0.f, 0.f, 0.f, 0.f};
            const float* wp = p.ada_w + (size_t)(kh * 512 + wave * 64) * 6144 + col;
#pragma unroll 16
            for (int k = 0; k < 64; ++k) {
                const float wv = wp[(size_t)k * 6144];
#pragma unroll
                for (int b = 0; b < 8; ++b) a[b] += sc[b * 512 + wave * 64 + k] * wv;
            }
#pragma unroll
            for (int b = 0; b < 8; ++b) red[(wave * 8 + b) * 64 + lane] = a[b];
            __syncthreads();
            {   const int b = wave; float s2 = 0.f;
#pragma unroll
                for (int w = 0; w < 8; ++w) s2 += red[(w * 8 + b) * 64 + lane];
                if (kh == 0) s2 += p.ada_b[col];
                atomicAdd(&mod[b * 6144 + col], s2); }
            __syncthreads();
            continue;
        }
        r -= T_ADA;
        if (r < T_MISC) {
            u16* wat = (u16*)(p.ws + OFF_WAT); u16* wxt = (u16*)(p.ws + OFF_WXT);
            for (int i = tid; i < 8 * 64 * 64; i += NTHREADS) {
                const int blk = i >> 12, co = (i >> 6) & 63, ci = i & 63;
                const float a = p.rg_wa[(blk * 64 + ci) * 64 + co], x = p.rg_wx[(blk * 64 + ci) * 64 + co];
                wat[i] = (u16)(pk2(a, 0.f) & 0xffff); wxt[i] = (u16)(pk2(x, 0.f) & 0xffff);
            }
            float* lsl = (float*)(p.ws + OFF_LSL);
            if (tid < 512) { const float l = p.rg_lambda[tid]; lsl[tid] = fminf(l, 0.f) - __logf(1.f + __expf(-fabsf(l)));   }
            continue;
        }
        r -= T_MISC;
        LAS float* T = (LAS float*)lds;
        transpose_tile(T, p.w_in, D, DIN, (u16*)(p.ws + OFF_WIN), r / (DIN / 128), r % (DIN / 128), false);
    }
}
struct TrItem { const float* W; u16* WT; int K, N, kt, ntl, perm; };
__device__ __forceinline__ TrItem prep2_item(const Params& p, int it) {
    constexpr int T_WUP = (D / 64) * (NUP / 128), T_WOUT = (D / 64) * (D / 128);
    TrItem t; int r = it;
    if (r < T_WOUT) { t.W = p.w_out; t.WT = (u16*)(p.ws + OFF_WOUT); t.K = D; t.N = D; t.kt = r / (D / 128); t.ntl = r % (D / 128); t.perm = 0; return t; }
    r -= T_WOUT;
    if (r < T_WUP) { t.W = p.w_up; t.WT = (u16*)(p.ws + OFF_WUP); t.K = D; t.N = NUP; t.kt = r / (NUP / 128); t.ntl = r % (NUP / 128); t.perm = 1; return t; }
    r -= T_WUP;
    t.W = p.w_down; t.WT = (u16*)(p.ws + OFF_WDN); t.K = DFF; t.N = D; t.kt = r / (D / 128); t.ntl = r % (D / 128); t.perm = 0; return t;
}
__device__ __forceinline__ void prep2_load(const TrItem& t, int tid, float4 (&v)[4]) {
    const int r = tid >> 5, c4 = tid & 31;
#pragma unroll
    for (int pass = 0; pass < 4; ++pass) v[pass] = *(const float4*)(t.W + (size_t)(t.kt * 64 + pass * 16 + r) * t.N + t.ntl * 128 + c4 * 4);
}
__device__ __forceinline__ void phase_prep2(const Params& p, LAS unsigned char* lds, int first) {
    constexpr int T_WUP = (D / 64) * (NUP / 128), T_WDN = (DFF / 64) * (D / 128), T_WOUT = (D / 64) * (D / 128);
    constexpr int NIT = T_WOUT + T_WUP + T_WDN;
    LAS float* T = (LAS float*)lds;
    const int nb = (int)gridDim.x - first;
    if ((int)blockIdx.x < first || nb <= 0) return;
    const int tid = opaque_tid();
    int it = (int)blockIdx.x - first;
    if (it >= NIT) return;
    TrItem cur = prep2_item(p, it);
    float4 v[4];
    prep2_load(cur, tid, v);
    __syncthreads();
    for (; it < NIT; it += nb) {
        const int r = tid >> 5, c4 = tid & 31;
#pragma unroll
        for (int pass = 0; pass < 4; ++pass) { LAS float* t = T + (pass * 16 + r) * 129 + c4 * 4; t[0] = v[pass].x; t[1] = v[pass].y; t[2] = v[pass].z; t[3] = v[pass].w; }
        __syncthreads();
        const bool has_next = it + nb < NIT;
        TrItem nxt = cur;
        if (has_next) { nxt = prep2_item(p, it + nb); prep2_load(nxt, tid, v); }
        const int n = tid >> 2, kq = tid & 3;
        unsigned o[8];
#pragma unroll
        for (int i = 0; i < 8; ++i) o[i] = pk2(T[(kq * 16 + 2 * i) * 129 + n], T[(kq * 16 + 2 * i + 1) * 129 + n]);
        int nrow = cur.ntl * 128 + n;
        if (cur.perm) { const int j = nrow < DFF ? nrow : nrow - DFF; nrow = (j >> 7) * 256 + (nrow < DFF ? 0 : 128) + (j & 127); }
        uint4* dst = (uint4*)(cur.WT + (size_t)nrow * cur.K + cur.kt * 64 + kq * 16);
        dst[0] = make_uint4(o[0], o[1], o[2], o[3]); dst[1] = make_uint4(o[4], o[5], o[6], o[7]);
        __syncthreads();
        cur = nxt;
    }
}

template <int MODE>
__device__ __forceinline__ void phase_norm(const float* src, const float* gain, const float* mod, int mo_sh, int mo_sc, u16* dst_bf, float* dst_f) {
    const int tid = opaque_tid(), wave = tid >> 6, lane = tid & 63;
    const int stride = gridDim.x * 16;
    int row0 = (blockIdx.x * 8 + wave) * 2;
    float4 v[2][4], vn[2][4];
    if (row0 < MTOK) {
#pragma unroll
        for (int q = 0; q < 2; ++q) {
            const float4* xr = (const float4*)(src + (size_t)(row0 + q) * D) + lane;
#pragma unroll
            for (int j = 0; j < 4; ++j) v[q][j] = xr[64 * j];
        }
    }
    for (; row0 < MTOK; row0 += stride) {
        const int rown = row0 + stride;
        if (rown < MTOK) {
#pragma unroll
            for (int q = 0; q < 2; ++q) {
                const float4* xr = (const float4*)(src + (size_t)(rown + q) * D) + lane;
#pragma unroll
                for (int j = 0; j < 4; ++j) vn[q][j] = xr[64 * j];
            }
        }
        float ss[2];
#pragma unroll
        for (int q = 0; q < 2; ++q) {
            float a = 0.f;
#pragma unroll
            for (int j = 0; j < 4; ++j) a += (v[q][j].x * v[q][j].x + v[q][j].y * v[q][j].y) + (v[q][j].z * v[q][j].z + v[q][j].w * v[q][j].w);
            ss[q] = wave_sum(a);
        }
        const int b = row0 / SEQ;
#pragma unroll
        for (int j = 0; j < 4; ++j) {
            const int col = (lane + 64 * j) * 4;
            float4 g = *(const float4*)(gain + col);
            float4 sh = make_float4(0.f, 0.f, 0.f, 0.f);
            if (MODE == 0) {
                const float4 sc = *(const float4*)(mod + b * 6144 + mo_sc + col); sh = *(const float4*)(mod + b * 6144 + mo_sh + col);
                g.x *= 1.f + sc.x; g.y *= 1.f + sc.y; g.z *= 1.f + sc.z; g.w *= 1.f + sc.w;
            }
#pragma unroll
            for (int q = 0; q < 2; ++q) {
                const float rinv = rsqrtf(ss[q] * (1.f / D) + EPS);
                const float y0 = v[q][j].x * rinv * g.x + sh.x, y1 = v[q][j].y * rinv * g.y + sh.y, y2 = v[q][j].z * rinv * g.z + sh.z, y3 = v[q][j].w * rinv * g.w + sh.w;
                if (MODE == 0) { uint2 o; o.x = pk2(y0, y1); o.y = pk2(y2, y3); *(uint2*)(dst_bf + (size_t)(row0 + q) * D + col) = o; }
                else *(float4*)(dst_f + (size_t)(row0 + q) * D + col) = make_float4(y0, y1, y2, y3);
            }
        }
#pragma unroll
        for (int q = 0; q < 2; ++q)
#pragma unroll
            for (int j = 0; j < 4; ++j) v[q][j] = vn[q][j];
    }
}

typedef float f32x16 __attribute__((ext_vector_type(16)));
__device__ __forceinline__ void phase_attn(const Params& p, LAS unsigned char* lds) {
    const int tid = opaque_tid(), h = tid >> 6, lane = tid & 63, l31 = lane & 31, g = lane >> 5;
    const u16* proj = (const u16*)(p.ws + OFF_PROJ);
    const u16* Vt = (const u16*)(p.ws + OFF_VT);
    const u16* Kf = (const u16*)(p.ws + OFF_KF);
    u16* ymix = (u16*)(p.ws + OFF_YMIX);
    const float L2E = 1.4426950408889634f;
    LAS float* Bs = (LAS float*)lds;
    __syncthreads();
    for (int i = tid; i < 8 * 257; i += NTHREADS) { const int hh = i / 257, j = i - hh * 257; Bs[hh * 260 + j] = p.rel_bias[i] * L2E; }
    __syncthreads();
    const LAS float* Bh = Bs + h * 260;
    const float bconst = Bh[256];
    for (int task = blockIdx.x; task < BATCH * 32; task += gridDim.x) {
        int n = task & 31, b = task >> 5;
        if (gridDim.x == 256) { b = task & 7; n = task >> 3; }
        const size_t tok0 = (size_t)b * SEQ + n * 64;
        LAS unsigned char* Qs = lds + 16384 + (tid >> 6) * 8192 + lane * 16;
#pragma unroll
        for (int hf = 0; hf < 2; ++hf)
#pragma unroll
            for (int ks = 0; ks < 4; ++ks) {
                const bf16x8 qv = *(const bf16x8*)(proj + (tok0 + hf * 32 + l31) * PST + C_Q + h * 64 + ks * 16 + g * 8);
                *(LAS bf16x8*)(Qs + (hf * 4 + ks) * 1024) = qv;
            }
        f32x16 o[2][2];
#pragma unroll
        for (int hf = 0; hf < 2; ++hf)
#pragma unroll
            for (int db = 0; db < 2; ++db)
#pragma unroll
                for (int i = 0; i < 16; ++i) o[hf][db][i] = 0.f;
        float mrun[2] = {-INFINITY, -INFINITY}, lrun[2] = {0.f, 0.f};
        const int cstart = n >= 8 ? 0 : 8 - n;
        const int hu = __builtin_amdgcn_readfirstlane(h);
        const u16* kbase = Kf + (size_t)(b * 8 + hu) * 64 * 2048 + lane * 8;
        const u16* vbase = Vt + (size_t)(b * 8 + hu) * 128 * 1024 + lane * 8;
        bf16x8 kf[2][4], vf[2][2][2];
        {   const int key0 = (n - 8 + cstart) * 64;
#pragma unroll
            for (int kb = 0; kb < 2; ++kb)
#pragma unroll
                for (int ks = 0; ks < 4; ++ks) kf[kb][ks] = *(const bf16x8*)(kbase + (((key0 >> 5) + kb) * 4 + ks) * 512);
#pragma unroll
            for (int db = 0; db < 2; ++db)
#pragma unroll
                for (int kb = 0; kb < 2; ++kb)
#pragma unroll
                    for (int u = 0; u < 2; ++u) vf[db][kb][u] = *(const bf16x8*)(vbase + ((((key0 >> 4) + kb * 2 + u) * 2 + db) * 512));
        }
        for (int c = cstart; c <= 8; ++c) {
            const bool cb = c <= 5;
            const int t2 = opaque_tid(), l31c = t2 & 31, gc = (t2 >> 5) & 1; const unsigned lo8 = (unsigned)(t2 & 63) * 8u;
            const u16* kb2 = Kf + (size_t)(b * 8 + hu) * 64 * 2048; const u16* vb2 = Vt + (size_t)(b * 8 + hu) * 128 * 1024;
#pragma unroll
            for (int hf = 0; hf < 2; ++hf) {
                __builtin_amdgcn_sched_barrier(0);
                f32x16 s_[2];
                bf16x8 qf[4];
#pragma unroll
                for (int ks = 0; ks < 4; ++ks) qf[ks] = *(const LAS bf16x8*)(lds + 16384 + (t2 >> 6) * 8192 + (t2 & 63) * 16 + (hf * 4 + ks) * 1024);
#pragma unroll
                for (int kb = 0; kb < 2; ++kb) {
#pragma unroll
                    for (int i = 0; i < 16; ++i) s_[kb][i] = 0.f;
#pragma unroll
                    for (int ks = 0; ks < 4; ++ks) s_[kb] = __builtin_amdgcn_mfma_f32_32x32x16_bf16(kf[kb][ks], qf[ks], s_[kb], 0, 0, 0);
                }
                if (hf == 1 && c < 8) {
                    const int key0 = (n - 8 + c + 1) * 64;
#pragma unroll
                    for (int kb = 0; kb < 2; ++kb)
#pragma unroll
                        for (int ks = 0; ks < 4; ++ks) kf[kb][ks] = *(const bf16x8*)(kb2 + (unsigned)((((key0 >> 5) + kb) * 4 + ks) * 512) + lo8);
                }
                float mx = -INFINITY;
                if (cb) {
#pragma unroll
                    for (int kb = 0; kb < 2; ++kb)
#pragma unroll
                        for (int i = 0; i < 16; ++i) mx = fmaxf(mx, s_[kb][i]);
                    mx = mx * (0.125f * L2E) + bconst;
                } else {
                    const int relb = 512 + hf * 32 + l31c - c * 64 - 4 * gc + 128;
#pragma unroll
                    for (int kb = 0; kb < 2; ++kb)
#pragma unroll
                        for (int i = 0; i < 16; ++i) {
                            int idx = relb - (kb * 32 + 8 * (i >> 2) + (i & 3));
                            idx = idx < 0 ? 0 : (idx > 256 ? 256 : idx);
                            const float v = s_[kb][i] * (0.125f * L2E) + Bh[idx]; s_[kb][i] = v; mx = fmaxf(mx, v);
                        }
                }
                mx = fmaxf(mx, __shfl_xor(mx, 32));
                const float mnew = fmaxf(mrun[hf], mx);
                const float alpha = __builtin_amdgcn_exp2f(mrun[hf] - mnew);
                mrun[hf] = mnew;
                float ls = 0.f;
                if (cb) {
                    const float off = bconst - mnew;
#pragma unroll
                    for (int kb = 0; kb < 2; ++kb)
#pragma unroll
                        for (int i = 0; i < 16; ++i) { const float pv = __builtin_amdgcn_exp2f(s_[kb][i] * (0.125f * L2E) + off); s_[kb][i] = pv; ls += pv; }
                } else {
#pragma unroll
                    for (int kb = 0; kb < 2; ++kb)
#pragma unroll
                        for (int i = 0; i < 16; ++i) { const float pv = __builtin_amdgcn_exp2f(s_[kb][i] - mnew); s_[kb][i] = pv; ls += pv; }
                }
                lrun[hf] = lrun[hf] * alpha + ls;
#pragma unroll
                for (int db = 0; db < 2; ++db)
#pragma unroll
                    for (int i = 0; i < 16; ++i) o[hf][db][i] *= alpha;
#pragma unroll
                for (int kb = 0; kb < 2; ++kb)
#pragma unroll
                    for (int u = 0; u < 2; ++u) {
                        union { bf16x8 v; unsigned w[4]; } pf;
                        pf.w[0] = pk2(s_[kb][8 * u + 0], s_[kb][8 * u + 1]); pf.w[1] = pk2(s_[kb][8 * u + 2], s_[kb][8 * u + 3]);
                        pf.w[2] = pk2(s_[kb][8 * u + 4], s_[kb][8 * u + 5]); pf.w[3] = pk2(s_[kb][8 * u + 6], s_[kb][8 * u + 7]);
#pragma unroll
                        for (int db = 0; db < 2; ++db) o[hf][db] = __builtin_amdgcn_mfma_f32_32x32x16_bf16(vf[db][kb][u], pf.v, o[hf][db], 0, 0, 0);
                    }
            }
            if (c < 8) {
                const int key0 = (n - 8 + c + 1) * 64;
#pragma unroll
                for (int db = 0; db < 2; ++db)
#pragma unroll
                    for (int kb = 0; kb < 2; ++kb)
#pragma unroll
                        for (int u = 0; u < 2; ++u) vf[db][kb][u] = *(const bf16x8*)(vb2 + (unsigned)((((key0 >> 4) + kb * 2 + u) * 2 + db) * 512) + lo8);
            }
        }
#pragma unroll
        for (int hf = 0; hf < 2; ++hf) {
            float lr = lrun[hf]; lr += __shfl_xor(lr, 32);
            const float inv = __builtin_amdgcn_rcpf(lr);
#pragma unroll
            for (int db = 0; db < 2; ++db)
#pragma unroll
                for (int k = 0; k < 4; k += 2) {
                    const unsigned a0 = pk2(o[hf][db][4 * k] * inv, o[hf][db][4 * k + 1] * inv), a1 = pk2(o[hf][db][4 * k + 2] * inv, o[hf][db][4 * k + 3] * inv);
                    const unsigned b0 = pk2(o[hf][db][4 * k + 4] * inv, o[hf][db][4 * k + 5] * inv), b1 = pk2(o[hf][db][4 * k + 6] * inv, o[hf][db][4 * k + 7] * inv);
                    const auto r0 = __builtin_amdgcn_permlane32_swap(a0, b0, false, false);
                    const auto r1 = __builtin_amdgcn_permlane32_swap(a1, b1, false, false);
                    *(u32x4*)(ymix + (tok0 + hf * 32 + l31) * D + DRNN + h * 64 + db * 32 + 8 * (k + g)) = (u32x4){(unsigned)r0[0], (unsigned)r1[0], (unsigned)r0[1], (unsigned)r1[1]};
                }
        }
    }
}

__device__ __forceinline__ void phase_rnn(const Params& p, LAS unsigned char* lds) {
    const int tid = opaque_tid(), wave = tid >> 6, lane = tid & 63, fr = lane & 15, fq = lane >> 4;
    const u16* proj = (const u16*)(p.ws + OFF_PROJ);
    const u16* wat = (const u16*)(p.ws + OFF_WAT); const u16* wxt = (const u16*)(p.ws + OFF_WXT);
    const float* lsl = (const float*)(p.ws + OFF_LSL);
    gu64* RT = (gu64*)(p.ws + OFF_RTOT);
    u16* ymix = (u16*)(p.ws + OFF_YMIX);
    LAS unsigned char* Xb = lds;
    LAS float* Xf = (LAS float*)(lds + 64 * 144);
    LAS float* Gt = Xf + 64 * 64;
    LAS float* Sg = Gt + 2 * 64 * 64;
    LAS float* Pt = Sg + 8 * 64 * 2;
    const int ctok = tid >> 3, cq = tid & 7;
    uint4 xv[4];
    const int NTASK = BATCH * 32 * 8;
    if ((int)blockIdx.x < NTASK) {
        const int task = blockIdx.x, nb = task & 7, b = (task >> 3) & 7, tt = task >> 6;
#pragma unroll
        for (int k = 0; k < 4; ++k) {
            const int ts = tt * 64 + ctok - 3 + k;
            xv[k] = ts >= 0 ? *(const uint4*)(proj + ((size_t)b * SEQ + ts) * PST + C_XR + nb * 64 + cq * 8) : make_uint4(0, 0, 0, 0);
        }
    }
    int cur_nb = -1;
    float cw[4][8], cbias[8], ba = 0.f, bx = 0.f, ll = 0.f;
    bf16x8 wfr[4][2];
    const int sel = wave & 1, mt = wave >> 1;
    for (int task = blockIdx.x; task < NTASK; task += gridDim.x) {
        const int nb = task & 7, b = (task >> 3) & 7, tt = task >> 6;
        if (nb != cur_nb) {
            cur_nb = nb;
            const int chc = nb * 64 + cq * 8;
            {   const float4 b0 = *(const float4*)(p.rnn_conv_b + chc), b1 = *(const float4*)(p.rnn_conv_b + chc + 4);
                cbias[0] = b0.x; cbias[1] = b0.y; cbias[2] = b0.z; cbias[3] = b0.w; cbias[4] = b1.x; cbias[5] = b1.y; cbias[6] = b1.z; cbias[7] = b1.w; }
#pragma unroll
            for (int k = 0; k < 4; ++k) {
                const float4 w0 = *(const float4*)(p.rnn_conv_w + k * DRNN + chc), w1 = *(const float4*)(p.rnn_conv_w + k * DRNN + chc + 4);
                cw[k][0] = w0.x; cw[k][1] = w0.y; cw[k][2] = w0.z; cw[k][3] = w0.w; cw[k][4] = w1.x; cw[k][5] = w1.y; cw[k][6] = w1.z; cw[k][7] = w1.w;
            }
            const int chl = nb * 64 + lane;
            ba = p.rg_ba[chl]; bx = p.rg_bx[chl]; ll = lsl[chl];
            const u16* wT = (sel ? wxt : wat) + nb * 4096;
#pragma unroll
            for (int nt = 0; nt < 4; ++nt)
#pragma unroll
                for (int ks = 0; ks < 2; ++ks) wfr[nt][ks] = *(const bf16x8*)(wT + (nt * 16 + fr) * 64 + ks * 32 + fq * 8);
        }
        __syncthreads();
        {   float xc[8];
#pragma unroll
            for (int j = 0; j < 8; ++j) xc[j] = cbias[j];
#pragma unroll
            for (int k = 0; k < 4; ++k) {
                xc[0] += cw[k][0] * bflo(xv[k].x); xc[1] += cw[k][1] * bfhi(xv[k].x); xc[2] += cw[k][2] * bflo(xv[k].y); xc[3] += cw[k][3] * bfhi(xv[k].y);
                xc[4] += cw[k][4] * bflo(xv[k].z); xc[5] += cw[k][5] * bfhi(xv[k].z); xc[6] += cw[k][6] * bflo(xv[k].w); xc[7] += cw[k][7] * bfhi(xv[k].w);
            }
            *(LAS u32x4*)(Xb + ctok * 144 + cq * 16) = (u32x4){pk2(xc[0], xc[1]), pk2(xc[2], xc[3]), pk2(xc[4], xc[5]), pk2(xc[6], xc[7])};
            LAS f32x4* xf = (LAS f32x4*)(Xf + ctok * 64 + cq * 8);
            xf[0] = (f32x4){xc[0], xc[1], xc[2], xc[3]}; xf[1] = (f32x4){xc[4], xc[5], xc[6], xc[7]};
        }
        {
            const int nt_ = task + (int)gridDim.x;
            if (nt_ < NTASK) {
                const int nb2 = nt_ & 7, b2 = (nt_ >> 3) & 7, tt2 = nt_ >> 6;
#pragma unroll
                for (int k = 0; k < 4; ++k) {
                    const int ts = tt2 * 64 + ctok - 3 + k;
                    xv[k] = ts >= 0 ? *(const uint4*)(proj + ((size_t)b2 * SEQ + ts) * PST + C_XR + nb2 * 64 + cq * 8) : make_uint4(0, 0, 0, 0);
                }
            }
        }
        const int ch = nb * 64 + lane;
        const size_t tokb = (size_t)b * SEQ + tt * 64 + wave * 8;
        u16 gr[8];
#pragma unroll
        for (int i = 0; i < 8; ++i) gr[i] = proj[(tokb + i) * PST + C_GR + ch];
        unsigned long long pg[4];
#pragma unroll
        for (int j = 0; j < 4; ++j) { const int s2 = wave + 8 * j; pg[j] = s2 < tt ? __hip_atomic_load(RT + ((size_t)(b * 32 + s2) * DRNN + ch), RLX_AGENT) : 1ull; }
        __syncthreads();
        {
            bf16x8 af[2];
#pragma unroll
            for (int ks = 0; ks < 2; ++ks) af[ks] = *(const LAS bf16x8*)(Xb + (mt * 16 + fr) * 144 + ks * 64 + fq * 16);
#pragma unroll
            for (int nt = 0; nt < 4; ++nt) {
                f32x4 d = (f32x4){0.f, 0.f, 0.f, 0.f};
#pragma unroll
                for (int ks = 0; ks < 2; ++ks) d = __builtin_amdgcn_mfma_f32_16x16x32_bf16(af[ks], wfr[nt][ks], d, 0, 0, 0);
#pragma unroll
                for (int r = 0; r < 4; ++r) Gt[(sel * 64 + mt * 16 + fq * 4 + r) * 64 + nt * 16 + fr] = d[r];
            }
        }
        __syncthreads();
        float acum[8], hloc[8];
        {   float A = 1.f, H = 0.f;
#pragma unroll
            for (int i = 0; i < 8; ++i) {
                const int tok = wave * 8 + i;
                const float r = sigmoidf_(Gt[tok * 64 + lane] + ba), ig = sigmoidf_(Gt[(64 + tok) * 64 + lane] + bx);
                const float a = __expf(8.f * r * ll);
                const float mult = __builtin_amdgcn_sqrtf(fmaxf(1.f - a * a, 0.f));
                const float bt = mult * (ig * Xf[tok * 64 + lane]);
                H = a * H + bt; A = A * a;
                acum[i] = A; hloc[i] = H;
            }
            Sg[(wave * 64 + lane) * 2] = A; Sg[(wave * 64 + lane) * 2 + 1] = H;
        }
        __syncthreads();
        {   float Ain = 1.f, Hin = 0.f;
            for (int s2 = 0; s2 < wave; ++s2) { const float as = Sg[(s2 * 64 + lane) * 2], hs = Sg[(s2 * 64 + lane) * 2 + 1]; Hin = as * Hin + hs; Ain *= as; }
#pragma unroll
            for (int i = 0; i < 8; ++i) { hloc[i] += acum[i] * Hin; acum[i] *= Ain; }
        }
        if (wave == 7) {
            const unsigned long long gv = ((unsigned long long)__float_as_uint(hloc[7]) << 32) | (unsigned long long)(__float_as_uint(acum[7]) | 1u);
            __hip_atomic_store(RT + ((size_t)(b * 32 + tt) * DRNN + ch), gv, RLX_AGENT);
        }
#pragma unroll
        for (int j = 0; j < 4; ++j) {
            const int s2 = wave + 8 * j;
            if (s2 < tt) {
                unsigned long long x = pg[j]; unsigned spins = 0;
                while ((unsigned)x == 0u) {
                    __builtin_amdgcn_s_sleep(1);
                    x = __hip_atomic_load(RT + ((size_t)(b * 32 + s2) * DRNN + ch), RLX_AGENT);
                    if (++spins > (1u << 22)) break;
                }
                Pt[(s2 * 64 + lane) * 2] = __uint_as_float((unsigned)x); Pt[(s2 * 64 + lane) * 2 + 1] = __uint_as_float((unsigned)(x >> 32));
            }
        }
        __syncthreads();
        {   float Hin = 0.f;
            for (int s2 = 0; s2 < tt; ++s2) Hin = Pt[(s2 * 64 + lane) * 2] * Hin + Pt[(s2 * 64 + lane) * 2 + 1];
#pragma unroll
            for (int i = 0; i < 8; ++i) {
                const float hv = hloc[i] + acum[i] * Hin;
                ymix[(tokb + i) * D + ch] = (u16)(pk2(hv * gelu_tanh(bflo((unsigned)gr[i])), 0.f) & 0xffff);
            }
        }
    }
}

__device__ __forceinline__ void phase_fix(const Params& p) {
    const u16* side = (const u16*)(p.ws + OFF_SIDE);
    u16* act = (u16*)(p.ws + OFF_PROJ);
    const float* cw = p.ffn_conv_w; const float* cb = p.ffn_conv_b;
    const int tid = opaque_tid();
    for (int t = opaque_bid(); t < (MTOK / 256) * (D / 256); t += gridDim.x) {
        const int pm = t % (MTOK / 256);
        for (int i = tid; i < 2 * DFF; i += NTHREADS) {
            const int j = i % DFF, rr = i / DFF;
            const int cu_ = (j >> 7) * 256 + (j & 127), cv_ = cu_ + 128;
            const bool first = (pm & 7) == 0;
            float u[3], v[3];
            const u16* sp = side + (size_t)pm * 4 * NUP;
            const u16* spp = side + (size_t)(first ? pm : pm - 1) * 4 * NUP;
            if (rr == 0) {
                u[0] = first ? 0.f : bflo(spp[2 * NUP + cu_]); u[1] = first ? 0.f : bflo(spp[3 * NUP + cu_]); u[2] = bflo(sp[cu_]);
                v[0] = first ? 0.f : bflo(spp[2 * NUP + cv_]); v[1] = first ? 0.f : bflo(spp[3 * NUP + cv_]); v[2] = bflo(sp[cv_]);
            } else {
                u[0] = first ? 0.f : bflo(spp[3 * NUP + cu_]); u[1] = bflo(sp[cu_]); u[2] = bflo(sp[NUP + cu_]);
                v[0] = first ? 0.f : bflo(spp[3 * NUP + cv_]); v[1] = bflo(sp[cv_]); v[2] = bflo(sp[NUP + cv_]);
            }
            const float gu = cw[j] * u[0] + cw[NUP + j] * u[1] + cw[2 * NUP + j] * u[2] + cb[j];
            const float gv = cw[DFF + j] * v[0] + cw[NUP + DFF + j] * v[1] + cw[2 * NUP + DFF + j] * v[2] + cb[DFF + j];
            act[(size_t)(pm * 256 + rr) * DFF + j] = (u16)(pk2(siluf_(gu) * gv, 0.f) & 0xffff);
        }
    }
    asm volatile("s_waitcnt vmcnt(0)" ::: "memory");
    __syncthreads();
}

constexpr int N_PHASES = 7;
#ifndef DUP
#define DUP 0
#endif
#ifndef PHM
#define PHM 0xffff
#endif
__global__ void __launch_bounds__(NTHREADS) fwd_megakernel(Params p_in) {
    extern __shared__ __attribute__((aligned(16))) unsigned char dyn_lds[];
    LAS unsigned char* lds = (LAS unsigned char*)dyn_lds;
    volatile LAS unsigned* xbst = (volatile LAS unsigned*)(lds + LDS_MAIN);
    if (threadIdx.x == 0) { xbst[0] = 0u; xbst[1] = 0u; xbst[2] = 0u; xbst[3] = 0u; }
    __syncthreads();
    const XcdBarrier xb = xcd_barrier_post((unsigned*)(p_in.ws + OFF_BAR), xbst);
    const Params& p0 = p_in;
    for (int ph = 0; ph < N_PHASES; ++ph) {
        Params p = p0; p.ws = p0.ws + opaque_zero();
        const float* mod = (const float*)(p.ws + OFF_MOD);
        unsigned long long* xch = (unsigned long long*)(p.ws + OFF_XCH);
        if (ph > 0) xcd_barrier(xb);
        for (int rep = 0; rep < (((DUP >> ph) & 1) ? 2 : 1); ++rep)
        switch (ph) {
        case 0: if (PHM & 1) phase_prep(p, lds); break;
        case 1: if (PHM & 2) phase_norm<0>(p.x, p.norm1_g, mod, MO_SH1, MO_SC1, (u16*)(p.ws + OFF_H), nullptr); break;
        case 2: if (PHM & 4) { EpiProj e{(u16*)(p.ws + OFF_PROJ), (u16*)(p.ws + OFF_KF), (u16*)(p.ws + OFF_VT)}; gemm_phase_stream(lds, (const u16*)(p.ws + OFF_H), (const u16*)(p.ws + OFF_WIN), DIN, D, e);
                  phase_prep2(p, lds, (MTOK / 256) * (DIN / 256) % (int)gridDim.x); } break;
        case 3: if (PHM & 8) { phase_attn(p, lds); if (DUP & 2048) phase_attn(p, lds); phase_rnn(p, lds); if (DUP & 4096) phase_rnn(p, lds); } break;
        case 4: if (PHM & 16) { EpiResidNorm<0> e{p.x, mod + MO_G1, (u16*)(p.ws + OFF_X1B), p.norm2_g, mod, MO_SH2, MO_SC2, (u16*)(p.ws + OFF_H), nullptr, xch, 1u};
                  gemm_phase(lds, (const u16*)(p.ws + OFF_YMIX), (const u16*)(p.ws + OFF_WOUT), D, D, e); } break;
        case 5: if (PHM & 32) { EpiUp e{(u16*)(p.ws + OFF_PROJ), (u16*)(p.ws + OFF_SIDE), p.ffn_conv_w, p.ffn_conv_b}; gemm_phase_up(lds, (const u16*)(p.ws + OFF_H), (const u16*)(p.ws + OFF_WUP), NUP, D, e); } break;
        case 6: if (PHM & 64) { phase_fix(p);
                  EpiResidNorm<1> e{nullptr, mod + MO_G2, (u16*)(p.ws + OFF_X1B), p.final_g, nullptr, 0, 0, nullptr, p.out, xch + 64 * 4 * 256, 2u};
                  gemm_phase(lds, (const u16*)(p.ws + OFF_PROJ), (const u16*)(p.ws + OFF_WDN), D, DFF, e); } break;
        }
    }
}

extern "C" void kernel_launch(void* const* d_in, const int* in_sizes, int n_in, void* d_out, int out_size, void* d_ws, size_t ws_size, hipStream_t stream) {
    static int grid = 0;
    if (grid == 0) {
        int dev = 0, cus = 0, per_cu = 0;
        hipGetDevice(&dev);
        hipDeviceGetAttribute(&cus, hipDeviceAttributeMultiprocessorCount, dev);
        hipFuncSetAttribute((const void*)fwd_megakernel, hipFuncAttributeMaxDynamicSharedMemorySize, LDS_BYTES);
        hipOccupancyMaxActiveBlocksPerMultiprocessor(&per_cu, (const void*)fwd_megakernel, NTHREADS, LDS_BYTES);
        if (per_cu < 1) { fprintf(stderr, "occupancy query says %d blocks/CU\n", per_cu); per_cu = 1; }
        if (per_cu > 1) per_cu = 1;
        grid = cus * per_cu;
        if (grid != 256) fprintf(stderr, "note: grid %d != 256: the fused row-norm exchange expects one 256x256 tile per workgroup in the N=1024 GEMM phases\n", grid);
        if (ws_size < WS_END) fprintf(stderr, "workspace too small: %zu < %zu\n", ws_size, (size_t)WS_END);
    }
    hipMemsetAsync((char*)d_ws + OFF_BAR, 0, ZERO_BYTES, stream);
    Params p{};
    const float** f = (const float**)&p;
    for (int i = 0; i < 21; ++i) f[i] = (const float*)d_in[i];
    p.out = (float*)d_out; p.ws = (unsigned char*)d_ws;
    p.ph_lo = 0; p.ph_hi = N_PHASES;
    void* args[] = {&p};
    hipError_t e = hipLaunchCooperativeKernel((const void*)fwd_megakernel, dim3(grid), dim3(NTHREADS), args, LDS_BYTES, stream);
    if (e != hipSuccess) fprintf(stderr, "cooperative launch failed: %s (grid %d)\n", hipGetErrorString(e), grid);
}
```
